# Optimizing an MI355X kernel written in HIP

```python
import jax, jax.numpy as jnp
from jax import lax
import numpy as np

D_MODEL = 1024
BATCH = 16
SEQ = 2048
DEPTH = 1

D_FF = 2816
W_A = D_MODEL // 2
H_A = 8
HD_A = W_A // H_A
W_B = D_MODEL - W_A
G_B = 8
CHUNK = 128
CONV_K = 31
N_MOD = 9
EPS = 1e-6
HALF = 0.5

kernel_name = "hybrid_gmlp_conformer_macaron_adaln"


def _rms_norm(x, g):
    xf = x.astype(jnp.float32)
    xf = xf * lax.rsqrt(jnp.mean(xf * xf, axis=-1, keepdims=True) + EPS)
    return (xf * g.astype(jnp.float32)).astype(x.dtype)


def _layer_norm(x, g, b):
    xf = x.astype(jnp.float32)
    mu = jnp.mean(xf, axis=-1, keepdims=True)
    xc = xf - mu
    var = jnp.mean(xc * xc, axis=-1, keepdims=True)
    y = xc * lax.rsqrt(var + EPS) * g.astype(jnp.float32) + b.astype(jnp.float32)
    return y.astype(x.dtype)


def _modulate(h, shift, scale):
    return h * (1 + scale[:, None, :]) + shift[:, None, :]


def _swiglu(h, w_in, w_out):
    gate, up = jnp.split(h @ w_in, 2, axis=-1)
    return (jax.nn.silu(gate) * up) @ w_out


def _hybrid_mixer(h, w_mix_in, gmlp_norm_g, gmlp_norm_b, w_spatial, b_spatial,
                  conv_w, conv_b, conv_norm_g, conv_norm_b, g_out_a, g_out_b, w_mix_out):
    bsz, seq, _ = h.shape
    proj = h @ w_mix_in
    u, v, a, g = jnp.split(proj, [W_A, 2 * W_A, 2 * W_A + W_B], axis=-1)

    v = _layer_norm(v, gmlp_norm_g, gmlp_norm_b)
    n_chunks = seq // CHUNK
    v = v.reshape(bsz, n_chunks, CHUNK, H_A, HD_A)
    causal = jnp.tril(jnp.ones((CHUNK, CHUNK), dtype=bool))
    w_s = jnp.where(causal[None], w_spatial, jnp.zeros_like(w_spatial))
    z = jnp.einsum('hts,bnshd->bnthd', w_s, v) + b_spatial.T[None, None, :, :, None]
    y_a = u * z.reshape(bsz, seq, W_A)

    glu = a * jax.nn.sigmoid(g)
    conv = lax.conv_general_dilated(
        glu, conv_w[:, None, :], window_strides=(1,), padding=[(CONV_K - 1, 0)],
        dimension_numbers=('NWC', 'WIO', 'NWC'), feature_group_count=W_B) + conv_b
    y_b = jax.nn.silu(_layer_norm(conv, conv_norm_g, conv_norm_b))

    y = jnp.concatenate([_rms_norm(y_a, g_out_a), _rms_norm(y_b, g_out_b)], axis=-1)
    return y @ w_mix_out


def setup_inputs(seed: int = 0) -> dict:
    key = jax.random.key(seed)
    ks = jax.random.split(key, 32)
    L, D = DEPTH, D_MODEL

    def nrm(k, shape, std):
        return std * jax.random.normal(k, shape, jnp.float32)

    def gain(k, shape):
        return 1.0 + 0.05 * jax.random.normal(k, shape, jnp.float32)

    return {
        "x": nrm(ks[0], (BATCH, SEQ, D), 1.0),
        "c": nrm(ks[1], (BATCH, D), 1.0),
        "w_ada": nrm(ks[2], (L, D, N_MOD * D), 0.5 * D ** -0.5),
        "b_ada": nrm(ks[3], (L, N_MOD * D), 0.02),
        "g_pre_f1": gain(ks[4], (L, D)),
        "g_post_f1": gain(ks[5], (L, D)),
        "w_f1_in": nrm(ks[6], (L, D, 2 * D_FF), D ** -0.5),
        "w_f1_out": nrm(ks[7], (L, D_FF, D), D_FF ** -0.5),
        "g_pre_m": gain(ks[8], (L, D)),
        "g_post_m": gain(ks[9], (L, D)),
        "w_mix_in": nrm(ks[10], (L, D, 2 * W_A + 2 * W_B), D ** -0.5),
        "gmlp_norm_g": gain(ks[11], (L, W_A)),
        "gmlp_norm_b": nrm(ks[12], (L, W_A), 0.02),
        "w_spatial": nrm(ks[13], (L, H_A, CHUNK, CHUNK), CHUNK ** -0.5),
        "b_spatial": gain(ks[14], (L, H_A, CHUNK)),
        "conv_w": nrm(ks[15], (L, CONV_K, W_B), CONV_K ** -0.5),
        "conv_b": nrm(ks[16], (L, W_B), 0.02),
        "conv_norm_g": gain(ks[17], (L, W_B)),
        "conv_norm_b": nrm(ks[18], (L, W_B), 0.02),
        "g_out_a": gain(ks[19], (L, W_A)),
        "g_out_b": gain(ks[20], (L, W_B)),
        "w_mix_out": nrm(ks[21], (L, W_A + W_B, D), (W_A + W_B) ** -0.5),
        "g_pre_f2": gain(ks[22], (L, D)),
        "g_post_f2": gain(ks[23], (L, D)),
        "w_f2_in": nrm(ks[24], (L, D, 2 * D_FF), D ** -0.5),
        "w_f2_out": nrm(ks[25], (L, D_FF, D), D_FF ** -0.5),
    }


def reference(x, c, w_ada, b_ada, g_pre_f1, g_post_f1, w_f1_in, w_f1_out,
              g_pre_m, g_post_m, w_mix_in, gmlp_norm_g, gmlp_norm_b, w_spatial, b_spatial,
              conv_w, conv_b, conv_norm_g, conv_norm_b, g_out_a, g_out_b, w_mix_out,
              g_pre_f2, g_post_f2, w_f2_in, w_f2_out):
    for l in range(DEPTH):
        ada = jax.nn.silu(c) @ w_ada[l] + b_ada[l]
        sh1, sc1, gt1, sh2, sc2, gt2, sh3, sc3, gt3 = jnp.split(ada, N_MOD, axis=-1)

        h = _modulate(_rms_norm(x, g_pre_f1[l]), sh1, sc1)
        x = x + HALF * gt1[:, None, :] * _rms_norm(_swiglu(h, w_f1_in[l], w_f1_out[l]), g_post_f1[l])

        h = _modulate(_rms_norm(x, g_pre_m[l]), sh2, sc2)
        y = _hybrid_mixer(h, w_mix_in[l], gmlp_norm_g[l], gmlp_norm_b[l], w_spatial[l], b_spatial[l],
                          conv_w[l], conv_b[l], conv_norm_g[l], conv_norm_b[l],
                          g_out_a[l], g_out_b[l], w_mix_out[l])
        x = x + gt2[:, None, :] * _rms_norm(y, g_post_m[l])

        h = _modulate(_rms_norm(x, g_pre_f2[l]), sh3, sc3)
        x = x + HALF * gt3[:, None, :] * _rms_norm(_swiglu(h, w_f2_in[l], w_f2_out[l]), g_post_f2[l])
    return x
```

```cpp
#include <hip/hip_runtime.h>
#include <cstdio>
#include <cstdint>

typedef unsigned short bf16;
constexpr int D = 1024, BATCH = 16, SEQ = 2048, M = BATCH * SEQ, DFF = 2816, WA = 512, NH = 8, HD = 64, CHUNK = 128, CONVK = 31, NMOD = 9;
constexpr float EPS = 1e-6f;

constexpr size_t MiB = 1u << 20;
constexpr size_t WS_CTL = 0, WS_ADA = 1 * MiB, WS_H = 48 * MiB, WS_HID = 112 * MiB, WS_Y = 288 * MiB, WS_F = 352 * MiB, WS_END = 480 * MiB;
constexpr size_t WS_U = WS_HID, WS_V = WS_HID + 32 * MiB, WS_GLU = WS_HID + 64 * MiB, WS_VLN = WS_HID + 96 * MiB;

__device__ __forceinline__ float bf2f(unsigned h) { return __uint_as_float(h << 16); }
__device__ __forceinline__ unsigned f2bf(float f) { unsigned u = __float_as_uint(f); return (u + 0x7fffu + ((u >> 16) & 1u)) >> 16; }
__device__ __forceinline__ unsigned pk2(float lo, float hi) { return f2bf(lo) | (f2bf(hi) << 16); }
__device__ __forceinline__ float wave_sum(float v) {
#pragma unroll
    for (int o = 1; o < 64; o <<= 1) v += __shfl_xor(v, o);
    return v;
}
__device__ __forceinline__ float silu_f(float v) { return v / (1.f + __expf(-v)); }
__device__ __forceinline__ float sigmoid_f(float v) { return 1.f / (1.f + __expf(-v)); }

__global__ void __launch_bounds__(512) k_ada(const float* __restrict__ c, const float* __restrict__ w_ada, const float* __restrict__ b_ada, float* __restrict__ ada) {
    __shared__ float sc[1024 * 16];
    __shared__ float red[8 * 16 * 64];
    const int tid = threadIdx.x, lane = tid & 63, wave = tid >> 6;
    for (int i = tid; i < 16 * 1024; i += 512) { const int b = i >> 10, k = i & 1023; sc[k * 16 + b] = silu_f(c[i]); }
    __syncthreads();
    for (int item = blockIdx.x; item < (NMOD * D) / 64; item += gridDim.x) {
        const int col = item * 64 + lane, k0 = wave * 128;
        float acc[16];
#pragma unroll
        for (int b = 0; b < 16; ++b) acc[b] = 0.f;
        for (int k = k0; k < k0 + 128; ++k) {
            const float wv = w_ada[(size_t)k * (NMOD * D) + col];
#pragma unroll
            for (int q = 0; q < 4; ++q) { const float4 s = *(const float4*)&sc[k * 16 + 4 * q];
                acc[4 * q + 0] += s.x * wv; acc[4 * q + 1] += s.y * wv; acc[4 * q + 2] += s.z * wv; acc[4 * q + 3] += s.w * wv; }
        }
#pragma unroll
        for (int b = 0; b < 16; ++b) red[(wave * 16 + b) * 64 + lane] = acc[b];
        __syncthreads();
        for (int o = tid; o < 1024; o += 512) { const int b = o >> 6, l = o & 63; float s = 0.f;
#pragma unroll
            for (int w = 0; w < 8; ++w) s += red[(w * 16 + b) * 64 + l];
            ada[b * (NMOD * D) + item * 64 + l] = s + b_ada[item * 64 + l]; }
        __syncthreads();
    }
}

struct EArgs { const float* xin; const float* f; float* xout; bf16* hout; const float* gpost; const float* gt; const float* gpre; const float* sc; const float* sh; float coef; int pad; };
__global__ void __launch_bounds__(512) k_rowpass(EArgs a) {
    const int lane = threadIdx.x & 63, gw = blockIdx.x * 8 + (threadIdx.x >> 6), ngw = gridDim.x * 8;
    for (int row = gw; row < M; row += ngw) {
        const int b = row / SEQ;
        float4 x[4];
#pragma unroll
        for (int j = 0; j < 4; ++j) x[j] = *(const float4*)(a.xin + (size_t)row * D + 4 * lane + 256 * j);
        if (a.f) {
            float4 f[4]; float ss = 0.f;
#pragma unroll
            for (int j = 0; j < 4; ++j) { f[j] = *(const float4*)(a.f + (size_t)row * D + 4 * lane + 256 * j); ss += f[j].x * f[j].x + f[j].y * f[j].y + f[j].z * f[j].z + f[j].w * f[j].w; }
            const float rstd = rsqrtf(wave_sum(ss) * (1.f / D) + EPS);
#pragma unroll
            for (int j = 0; j < 4; ++j) { const int col = 4 * lane + 256 * j; const float4 g = *(const float4*)(a.gpost + col), t = *(const float4*)(a.gt + (size_t)b * (NMOD * D) + col);
                x[j].x += a.coef * t.x * (f[j].x * rstd * g.x); x[j].y += a.coef * t.y * (f[j].y * rstd * g.y); x[j].z += a.coef * t.z * (f[j].z * rstd * g.z); x[j].w += a.coef * t.w * (f[j].w * rstd * g.w);
                *(float4*)(a.xout + (size_t)row * D + col) = x[j]; }
        }
        if (a.hout) {
            float ss = 0.f;
#pragma unroll
            for (int j = 0; j < 4; ++j) ss += x[j].x * x[j].x + x[j].y * x[j].y + x[j].z * x[j].z + x[j].w * x[j].w;
            const float rstd = rsqrtf(wave_sum(ss) * (1.f / D) + EPS);
#pragma unroll
            for (int j = 0; j < 4; ++j) { const int col = 4 * lane + 256 * j; const float4 g = *(const float4*)(a.gpre + col), s = *(const float4*)(a.sc + (size_t)b * (NMOD * D) + col), h = *(const float4*)(a.sh + (size_t)b * (NMOD * D) + col);
                const float o0 = x[j].x * rstd * g.x * (1.f + s.x) + h.x, o1 = x[j].y * rstd * g.y * (1.f + s.y) + h.y, o2 = x[j].z * rstd * g.z * (1.f + s.z) + h.z, o3 = x[j].w * rstd * g.w * (1.f + s.w) + h.w;
                uint2 w; w.x = pk2(o0, o1); w.y = pk2(o2, o3); *(uint2*)(a.hout + (size_t)row * D + col) = w; }
        }
    }
}

struct EpSwiglu { bf16* hid; __device__ __forceinline__ void operator()(int r, int n, float g, float u) const { hid[(size_t)r * DFF + n] = (bf16)f2bf(silu_f(g) * u); } };
struct EpF32 { float* C; __device__ __forceinline__ void operator()(int r, int n, float v, float) const { C[(size_t)r * D + n] = v; } };
struct EpUV { bf16* U; bf16* V; __device__ __forceinline__ void operator()(int r, int n, float v, float) const { if (n < WA) U[(size_t)r * WA + n] = (bf16)f2bf(v); else V[(size_t)r * WA + n - WA] = (bf16)f2bf(v); } };
struct EpGlu { bf16* G; __device__ __forceinline__ void operator()(int r, int n, float a, float g) const { G[(size_t)r * WA + n] = (bf16)f2bf(a * sigmoid_f(g)); } };

template <bool PAIR, class Epi>
__global__ void __launch_bounds__(256) ngemm(const bf16* __restrict__ A, int lda, const float* __restrict__ W, int ldw, int K, int pair_off, Epi epi) {
    __shared__ float As[16][68];
    __shared__ float B0[16][68];
    __shared__ float B1[16][68];
    const int tid = threadIdx.x, tx = tid & 15, ty = tid >> 4;
    const int m0 = blockIdx.y * 64, n0 = blockIdx.x * 64;
    float acc0[4][4], acc1[4][4];
#pragma unroll
    for (int i = 0; i < 4; ++i)
#pragma unroll
        for (int j = 0; j < 4; ++j) { acc0[i][j] = 0.f; acc1[i][j] = 0.f; }
    for (int k0 = 0; k0 < K; k0 += 16) {
        { const int r = tid >> 2, kq = (tid & 3) * 4; const uint2 v = *(const uint2*)(A + (size_t)(m0 + r) * lda + k0 + kq);
          As[kq + 0][r] = bf2f(v.x & 0xffffu); As[kq + 1][r] = bf2f(v.x >> 16); As[kq + 2][r] = bf2f(v.y & 0xffffu); As[kq + 3][r] = bf2f(v.y >> 16); }
        { const int kk = tid >> 4, nq = (tid & 15) * 4; *(float4*)&B0[kk][nq] = *(const float4*)(W + (size_t)(k0 + kk) * ldw + n0 + nq);
          if (PAIR) *(float4*)&B1[kk][nq] = *(const float4*)(W + (size_t)(k0 + kk) * ldw + n0 + pair_off + nq); }
        __syncthreads();
#pragma unroll
        for (int kk = 0; kk < 16; ++kk) {
            const float4 a = *(const float4*)&As[kk][ty * 4], b0 = *(const float4*)&B0[kk][tx * 4];
            const float av[4] = {a.x, a.y, a.z, a.w}, bv[4] = {b0.x, b0.y, b0.z, b0.w};
#pragma unroll
            for (int i = 0; i < 4; ++i)
#pragma unroll
                for (int j = 0; j < 4; ++j) acc0[i][j] += av[i] * bv[j];
            if (PAIR) { const float4 b1 = *(const float4*)&B1[kk][tx * 4]; const float cv[4] = {b1.x, b1.y, b1.z, b1.w};
#pragma unroll
                for (int i = 0; i < 4; ++i)
#pragma unroll
                    for (int j = 0; j < 4; ++j) acc1[i][j] += av[i] * cv[j]; }
        }
        __syncthreads();
    }
#pragma unroll
    for (int i = 0; i < 4; ++i)
#pragma unroll
        for (int j = 0; j < 4; ++j) epi(m0 + ty * 4 + i, n0 + tx * 4 + j, acc0[i][j], acc1[i][j]);
}

__global__ void __launch_bounds__(512) k_lnv(const bf16* __restrict__ V, const float* __restrict__ g, const float* __restrict__ bta, bf16* __restrict__ VLN) {
    const int lane = threadIdx.x & 63, gw = blockIdx.x * 8 + (threadIdx.x >> 6), ngw = gridDim.x * 8;
    for (int row = gw; row < M; row += ngw) {
        const uint4 w = *(const uint4*)(V + (size_t)row * WA + 8 * lane);
        float v[8] = {bf2f(w.x & 0xffffu), bf2f(w.x >> 16), bf2f(w.y & 0xffffu), bf2f(w.y >> 16), bf2f(w.z & 0xffffu), bf2f(w.z >> 16), bf2f(w.w & 0xffffu), bf2f(w.w >> 16)};
        float s = 0.f;
#pragma unroll
        for (int i = 0; i < 8; ++i) s += v[i];
        const float mu = wave_sum(s) * (1.f / WA); float q = 0.f;
#pragma unroll
        for (int i = 0; i < 8; ++i) { v[i] -= mu; q += v[i] * v[i]; }
        const float rstd = rsqrtf(wave_sum(q) * (1.f / WA) + EPS);
        float o[8];
#pragma unroll
        for (int i = 0; i < 8; ++i) o[i] = v[i] * rstd * g[8 * lane + i] + bta[8 * lane + i];
        uint4 r; r.x = pk2(o[0], o[1]); r.y = pk2(o[2], o[3]); r.z = pk2(o[4], o[5]); r.w = pk2(o[6], o[7]);
        *(uint4*)(VLN + (size_t)row * WA + 8 * lane) = r;
    }
}
__global__ void __launch_bounds__(512) k_gmlp(const bf16* __restrict__ U, const bf16* __restrict__ VLN, const float* __restrict__ wsp, const float* __restrict__ bsp, float* __restrict__ YA) {
    const int row = blockIdx.x, col = threadIdx.x, t = row & (CHUNK - 1), h = col >> 6, r0 = row - t;
    const float* w = wsp + ((size_t)h * CHUNK + t) * CHUNK;
    float z = 0.f;
    for (int s = 0; s <= t; ++s) z += w[s] * bf2f(VLN[(size_t)(r0 + s) * WA + col]);
    z += bsp[h * CHUNK + t];
    YA[(size_t)row * WA + col] = bf2f(U[(size_t)row * WA + col]) * z;
}
__global__ void __launch_bounds__(512) k_conv(const bf16* __restrict__ GLU, const float* __restrict__ cw, const float* __restrict__ cb, float* __restrict__ CV) {
    const int row = blockIdx.x, c = threadIdx.x, p = row % SEQ;
    float s = 0.f;
#pragma unroll
    for (int j = 0; j < CONVK; ++j) { const int pp = p - (CONVK - 1) + j; if (pp >= 0) s += cw[j * WA + c] * bf2f(GLU[(size_t)(row - (CONVK - 1) + j) * WA + c]); }
    CV[(size_t)row * WA + c] = s + cb[c];
}
__global__ void __launch_bounds__(512) k_mixnorm(const float* __restrict__ YA, const float* __restrict__ CV, const float* __restrict__ cng, const float* __restrict__ cnb,
                                                 const float* __restrict__ goa, const float* __restrict__ gob, bf16* __restrict__ Y) {
    const int lane = threadIdx.x & 63, gw = blockIdx.x * 8 + (threadIdx.x >> 6), ngw = gridDim.x * 8;
    for (int row = gw; row < M; row += ngw) {
        float a[8], c[8];
#pragma unroll
        for (int q = 0; q < 2; ++q) { const float4 t = *(const float4*)(YA + (size_t)row * WA + 8 * lane + 4 * q); a[4 * q] = t.x; a[4 * q + 1] = t.y; a[4 * q + 2] = t.z; a[4 * q + 3] = t.w;
            const float4 u = *(const float4*)(CV + (size_t)row * WA + 8 * lane + 4 * q); c[4 * q] = u.x; c[4 * q + 1] = u.y; c[4 * q + 2] = u.z; c[4 * q + 3] = u.w; }
        float sa = 0.f, sc = 0.f;
#pragma unroll
        for (int i = 0; i < 8; ++i) { sa += a[i] * a[i]; sc += c[i]; }
        const float ra = rsqrtf(wave_sum(sa) * (1.f / WA) + EPS), mu = wave_sum(sc) * (1.f / WA);
        float q = 0.f;
#pragma unroll
        for (int i = 0; i < 8; ++i) { c[i] -= mu; q += c[i] * c[i]; }
        const float rc = rsqrtf(wave_sum(q) * (1.f / WA) + EPS);
        float sb = 0.f;
#pragma unroll
        for (int i = 0; i < 8; ++i) { c[i] = silu_f(c[i] * rc * cng[8 * lane + i] + cnb[8 * lane + i]); sb += c[i] * c[i]; }
        const float rb = rsqrtf(wave_sum(sb) * (1.f / WA) + EPS);
        float oa[8], ob[8];
#pragma unroll
        for (int i = 0; i < 8; ++i) { oa[i] = a[i] * ra * goa[8 * lane + i]; ob[i] = c[i] * rb * gob[8 * lane + i]; }
        uint4 r; r.x = pk2(oa[0], oa[1]); r.y = pk2(oa[2], oa[3]); r.z = pk2(oa[4], oa[5]); r.w = pk2(oa[6], oa[7]);
        *(uint4*)(Y + (size_t)row * D + 8 * lane) = r;
        r.x = pk2(ob[0], ob[1]); r.y = pk2(ob[2], ob[3]); r.z = pk2(ob[4], ob[5]); r.w = pk2(ob[6], ob[7]);
        *(uint4*)(Y + (size_t)row * D + WA + 8 * lane) = r;
    }
}

extern "C" void kernel_launch(void* const* d_in, const int* in_sizes, int n_in, void* d_out, int out_size, void* d_ws, size_t ws_size, hipStream_t stream) {
    if (n_in != 26 || in_sizes[0] != M * D || out_size != M * D || ws_size < WS_END) { fprintf(stderr, "kernel_launch: unexpected shapes (n_in %d, in0 %d, out %d, ws %zu)\n", n_in, n_in > 0 ? in_sizes[0] : -1, out_size, ws_size); return; }
    const float* const* in = (const float* const*)d_in;
    const float *x = in[0], *c = in[1], *w_ada = in[2], *b_ada = in[3], *g_pre_f1 = in[4], *g_post_f1 = in[5], *w_f1_in = in[6], *w_f1_out = in[7], *g_pre_m = in[8], *g_post_m = in[9], *w_mix_in = in[10],
                *gmlp_g = in[11], *gmlp_b = in[12], *w_sp = in[13], *b_sp = in[14], *conv_w = in[15], *conv_b = in[16], *cn_g = in[17], *cn_b = in[18], *g_out_a = in[19], *g_out_b = in[20], *w_mix_out = in[21],
                *g_pre_f2 = in[22], *g_post_f2 = in[23], *w_f2_in = in[24], *w_f2_out = in[25];
    unsigned char* ws = (unsigned char*)d_ws; float* out = (float*)d_out;
    float* ada = (float*)(ws + WS_ADA); bf16* H = (bf16*)(ws + WS_H); bf16* HID = (bf16*)(ws + WS_HID); bf16* Y = (bf16*)(ws + WS_Y); float* F = (float*)(ws + WS_F);
    bf16 *U = (bf16*)(ws + WS_U), *V = (bf16*)(ws + WS_V), *GLU = (bf16*)(ws + WS_GLU), *VLN = (bf16*)(ws + WS_VLN);
    float *YA = F, *CV = F + (size_t)M * WA;
    const float *sh1 = ada, *sc1 = ada + D, *gt1 = ada + 2 * D, *sh2 = ada + 3 * D, *sc2 = ada + 4 * D, *gt2 = ada + 5 * D, *sh3 = ada + 6 * D, *sc3 = ada + 7 * D, *gt3 = ada + 8 * D;

    k_ada<<<144, 512, 0, stream>>>(c, w_ada, b_ada, ada);
    k_rowpass<<<1024, 512, 0, stream>>>(EArgs{x, nullptr, nullptr, H, nullptr, nullptr, g_pre_f1, sc1, sh1, 0.f, 0});
    ngemm<true, EpSwiglu><<<dim3(DFF / 64, M / 64), 256, 0, stream>>>(H, D, w_f1_in, 2 * DFF, D, DFF, EpSwiglu{HID});
    ngemm<false, EpF32><<<dim3(D / 64, M / 64), 256, 0, stream>>>(HID, DFF, w_f1_out, D, DFF, 0, EpF32{F});
    k_rowpass<<<1024, 512, 0, stream>>>(EArgs{x, F, out, H, g_post_f1, gt1, g_pre_m, sc2, sh2, 0.5f, 0});
    ngemm<false, EpUV><<<dim3(2 * WA / 64, M / 64), 256, 0, stream>>>(H, D, w_mix_in, 4 * WA, D, 0, EpUV{U, V});
    ngemm<true, EpGlu><<<dim3(WA / 64, M / 64), 256, 0, stream>>>(H, D, w_mix_in + 2 * WA, 4 * WA, D, WA, EpGlu{GLU});
    k_lnv<<<1024, 512, 0, stream>>>(V, gmlp_g, gmlp_b, VLN);
    k_gmlp<<<M, 512, 0, stream>>>(U, VLN, w_sp, b_sp, YA);
    k_conv<<<M, 512, 0, stream>>>(GLU, conv_w, conv_b, CV);
    k_mixnorm<<<1024, 512, 0, stream>>>(YA, CV, cn_g, cn_b, g_out_a, g_out_b, Y);
    ngemm<false, EpF32><<<dim3(D / 64, M / 64), 256, 0, stream>>>(Y, D, w_mix_out, D, D, 0, EpF32{F});
    k_rowpass<<<1024, 512, 0, stream>>>(EArgs{out, F, out, H, g_post_m, gt2, g_pre_f2, sc3, sh3, 1.0f, 0});
    ngemm<true, EpSwiglu><<<dim3(DFF / 64, M / 64), 256, 0, stream>>>(H, D, w_f2_in, 2 * DFF, D, DFF, EpSwiglu{HID});
    ngemm<false, EpF32><<<dim3(D / 64, M / 64), 256, 0, stream>>>(HID, DFF, w_f2_out, D, DFF, 0, EpF32{F});
    k_rowpass<<<1024, 512, 0, stream>>>(EArgs{out, F, out, nullptr, g_post_f2, gt3, nullptr, nullptr, nullptr, 0.5f, 0});
}
```

```cpp
#include <hip/hip_runtime.h>
#include <cstdio>
#include <cstdint>
namespace pg8 {
#define PG8_LAS __attribute__((address_space(3)))
typedef unsigned short bf16_t;
typedef short bf16x8 __attribute__((ext_vector_type(8)));
typedef float f32x4 __attribute__((ext_vector_type(4)));
typedef unsigned u32x4 __attribute__((ext_vector_type(4)));
constexpr int BM = 256, BK = 64, HALF = 128, HTB = HALF * BK * 2  , STAGE_BYTES = 8 * HTB, NXCD = 8, WGM = 8;

__host__ __device__ __forceinline__ int lds_byte(int r, int c) { const int st = (r >> 4) * 2 + (c >> 5), rr = r & 15, cc = c & 31, ob = rr * 64 + cc * 2; return st * 1024 + (ob ^ (((ob >> 9) & 1) << 5)); }
__host__ __device__ __forceinline__ void stage_rc(int b, int& R, int& C) { const int st = b / 1024, sb = b % 1024, swz = sb ^ (((sb >> 9) & 1) << 5); R = (st >> 1) * 16 + swz / 64; C = (st & 1) * 32 + (swz % 64) / 2; }
__host__ __device__ __forceinline__ int perm32(int rho) { const int n = rho >> 4, i = rho & 15; return 8 * (i >> 2) + 4 * n + (i & 3); }

struct Unit { int pm, pn; };
struct Gemm { const bf16_t* A; const bf16_t* Bt; int M, N, K; };

struct StaticOrder {
    int nM, nN, nwg, G, c;
    __host__ __device__ void init(int M, int N, int G_, int c_) { nM = M / BM; nN = N / BM; nwg = nM * nN; G = G_; c = c_; }
    __host__ __device__ bool next(int i, Unit& u) const {
        const long L = (long)i * G + c; if (L >= nwg) return false;
        int wgid = (int)L; { const int q = nwg / NXCD, r = nwg % NXCD, xcd = wgid % NXCD, off = wgid / NXCD; wgid = (xcd < r ? xcd * (q + 1) : r * (q + 1) + (xcd - r) * q) + off; }
        const int nig = WGM * nN, gid = wgid / nig, fm = gid * WGM, gsz = (nM - fm) < WGM ? (nM - fm) : WGM;
        u.pm = fm + ((wgid % nig) % gsz); u.pn = (wgid % nig) / gsz; return true;
    }
    __device__ __forceinline__ void a_ready(const Unit&) const {}
    __device__ __forceinline__ void done(const Unit&) const {}
};
__device__ __forceinline__ unsigned cvt_pk_bf16(float lo, float hi) { unsigned r; asm volatile("v_cvt_pk_bf16_f32 %0, %1, %2" : "=v"(r) : "v"(lo), "v"(hi)); return r; }
typedef float f32x2 __attribute__((ext_vector_type(2)));
__device__ __forceinline__ float fast_sigmoid(float v) { return __builtin_amdgcn_rcpf(1.0f + __builtin_amdgcn_exp2f(v * -1.4426950408889634f)); }
struct EpiF32 {
    static constexpr bool PERM = false, AFTER_DRAIN = false;
    float* C; int ldc;
    __device__ __forceinline__ void operator()(const f32x4 (&acc)[2][2][4][2], const Unit& u, int wr, int wc, int fr, int fq) const {
        const int row0 = u.pm * BM + wr * 64 + fr, col0 = u.pn * BM + wc * 32 + 4 * fq;
#pragma unroll
        for (int ai = 0; ai < 2; ++ai)
#pragma unroll
            for (int m = 0; m < 4; ++m) { float* rowp = C + (size_t)(row0 + ai * HALF + m * 16) * ldc + col0;
#pragma unroll
                for (int bj = 0; bj < 2; ++bj)
#pragma unroll
                    for (int n = 0; n < 2; ++n) *(f32x4*)(rowp + bj * HALF + n * 16) = acc[ai][bj][m][n]; }
    }
};
struct EpiSwiglu {
    static constexpr bool PERM = true, AFTER_DRAIN = false;
    bf16_t* O; int ldc;
    __device__ __forceinline__ void operator()(const f32x4 (&acc)[2][2][4][2], const Unit& u, int wr, int wc, int fr, int fq) const {
        const int row0 = u.pm * BM + wr * 64 + fr, col0 = u.pn * HALF + wc * 32 + 8 * fq;
#pragma unroll
        for (int ai = 0; ai < 2; ++ai)
#pragma unroll
            for (int m = 0; m < 4; ++m) { bf16_t* rowp = O + (size_t)(row0 + ai * HALF + m * 16) * ldc + col0;
                float h[8];
#pragma unroll
                for (int n = 0; n < 2; ++n)
#pragma unroll
                    for (int e = 0; e < 4; ++e) { const float g = acc[ai][0][m][n][e], up = acc[ai][1][m][n][e]; h[4 * n + e] = g * fast_sigmoid(g) * up; }
                u32x4 w; w.x = cvt_pk_bf16(h[0], h[1]); w.y = cvt_pk_bf16(h[2], h[3]); w.z = cvt_pk_bf16(h[4], h[5]); w.w = cvt_pk_bf16(h[6], h[7]);
                *(u32x4*)rowp = w; }
    }
};
struct EpiMixIn {
    static constexpr bool PERM = true, AFTER_DRAIN = false;
    bf16_t* U; bf16_t* V; bf16_t* G;
    __device__ __forceinline__ void operator()(const f32x4 (&acc)[2][2][4][2], const Unit& u, int wr, int wc, int fr, int fq) const {
        const int row0 = u.pm * BM + wr * 64 + fr;
        if (u.pn < 4) {
            bf16_t* dst = (u.pn < 2 ? U : V) + (u.pn & 1) * BM + wc * 32 + 8 * fq;
#pragma unroll
            for (int ai = 0; ai < 2; ++ai)
#pragma unroll
                for (int m = 0; m < 4; ++m) { bf16_t* rowp = dst + (size_t)(row0 + ai * HALF + m * 16) * 512;
#pragma unroll
                    for (int bj = 0; bj < 2; ++bj) { const f32x4 v0 = acc[ai][bj][m][0], v1 = acc[ai][bj][m][1];
                        u32x4 w; w.x = cvt_pk_bf16(v0[0], v0[1]); w.y = cvt_pk_bf16(v0[2], v0[3]); w.z = cvt_pk_bf16(v1[0], v1[1]); w.w = cvt_pk_bf16(v1[2], v1[3]);
                        *(u32x4*)(rowp + bj * HALF) = w; } }
        } else {
            bf16_t* dst = G + (u.pn - 4) * HALF + wc * 32 + 8 * fq;
#pragma unroll
            for (int ai = 0; ai < 2; ++ai)
#pragma unroll
                for (int m = 0; m < 4; ++m) { bf16_t* rowp = dst + (size_t)(row0 + ai * HALF + m * 16) * 512;
                    float h[8];
#pragma unroll
                    for (int n = 0; n < 2; ++n)
#pragma unroll
                        for (int e = 0; e < 4; ++e) h[4 * n + e] = acc[ai][0][m][n][e] * fast_sigmoid(acc[ai][1][m][n][e]);
                    u32x4 w; w.x = cvt_pk_bf16(h[0], h[1]); w.y = cvt_pk_bf16(h[2], h[3]); w.z = cvt_pk_bf16(h[4], h[5]); w.w = cvt_pk_bf16(h[6], h[7]);
                    *(u32x4*)rowp = w; }
        }
    }
};
template <class Epi, class Sched, bool ALIGN_EPI = false, bool SP2 = false>
__device__ __forceinline__ void gemm_phase(PG8_LAS unsigned char* lds, const Gemm g, const Sched& S, const Epi& E) {
    const int tid = threadIdx.x, wid = __builtin_amdgcn_readfirstlane(tid >> 6), lane = tid & 63, wr = wid >> 2, wc = wid & 3, fr = lane & 15, fq = lane >> 4;
    const int K = g.K, nt = K / BK;
    unsigned voffA[2], voffB[2];
#pragma unroll
    for (int i = 0; i < 2; ++i) { int R, C; stage_rc(tid * 16 + i * 8192, R, C); const int Rb = Epi::PERM ? ((R & ~31) + perm32(R & 31)) : R;
        voffA[i] = (unsigned)(R * K + C) * 2u; voffB[i] = (unsigned)(Rb * K + C) * 2u; }
    const size_t kstep = (size_t)(BK * 2);
    const size_t hstep = (size_t)HALF * K * 2;
    const size_t tstep = 2 * hstep;
    const unsigned ldsw = (unsigned)wid * 1024u;
    const int aoff = lds_byte(wr * 64 + fr, fq * 8), boff = lds_byte(wc * 32 + fr, fq * 8);
#define PG8_SA(b, h) (((b) * 2 + (h)) * HTB)
#define PG8_SB(b, h) ((4 + (b) * 2 + (h)) * HTB)
#define PG8_STAGE(bufoff, gbase, voff) do { _Pragma("unroll") for (int _i = 0; _i < 2; ++_i) \
        __builtin_amdgcn_global_load_lds((const unsigned*)((const char*)(gbase) + (voff)[_i]), (PG8_LAS unsigned*)(lds + (bufoff) + ldsw + _i * 8192), 16, 0, 0); } while (0)
#define PG8_LDA(dst, b, h) do { _Pragma("unroll") for (int m = 0; m < 4; ++m) _Pragma("unroll") for (int k = 0; k < 2; ++k) dst[m][k] = *(const PG8_LAS bf16x8*)(lds + PG8_SA(b, h) + aoff + m * 2048 + k * 1024); } while (0)
#define PG8_LDB(dst, b, h) do { _Pragma("unroll") for (int n = 0; n < 2; ++n) _Pragma("unroll") for (int k = 0; k < 2; ++k) dst[n][k] = *(const PG8_LAS bf16x8*)(lds + PG8_SB(b, h) + boff + n * 2048 + k * 1024); } while (0)
#define PG8_MMA(ai, bj, At, Bt) do { __builtin_amdgcn_s_setprio(1); _Pragma("unroll") for (int m = 0; m < 4; ++m) _Pragma("unroll") for (int n = 0; n < 2; ++n) _Pragma("unroll") for (int k = 0; k < 2; ++k) \
        acc[ai][bj][m][n] = __builtin_amdgcn_mfma_f32_16x16x32_bf16(Bt[n][k], At[m][k], acc[ai][bj][m][n], 0, 0, 0); __builtin_amdgcn_s_setprio(0); } while (0)
#define PG8_WAIT_V(n) asm volatile("s_waitcnt vmcnt(" #n ")" ::: "memory")
#define PG8_WAIT_L(n) asm volatile("s_waitcnt lgkmcnt(" #n ")" ::: "memory")
#define PG8_BAR __builtin_amdgcn_s_barrier()
#define PG8_SCHED __builtin_amdgcn_sched_barrier(0)
    Unit cur, nxt; int ui = 0;
    if (!S.next(0, cur)) return;
    f32x4 acc[2][2][4][2];
#pragma unroll
    for (int a = 0; a < 2; ++a)
#pragma unroll
        for (int b = 0; b < 2; ++b)
#pragma unroll
            for (int m = 0; m < 4; ++m)
#pragma unroll
                for (int n = 0; n < 2; ++n) acc[a][b][m][n] = (f32x4){0.f, 0.f, 0.f, 0.f};
    bf16x8 At[4][2], B0[2][2], B1[2][2];
    const char* cA = (const char*)g.A + (size_t)cur.pm * tstep; const char* cB = (const char*)g.Bt + (size_t)cur.pn * tstep;
    S.a_ready(cur);
    if constexpr (SP2) {
        PG8_STAGE(PG8_SB(0, 0), cB, voffB); PG8_STAGE(PG8_SB(0, 1), cB + hstep, voffB); PG8_STAGE(PG8_SA(0, 0), cA, voffA); PG8_STAGE(PG8_SA(0, 1), cA + hstep, voffA);
        if (wr == 1) PG8_BAR;
        PG8_WAIT_V(2); PG8_BAR;
        PG8_STAGE(PG8_SB(1, 0), cB + kstep, voffB); PG8_STAGE(PG8_SA(1, 0), cA + kstep, voffA); PG8_STAGE(PG8_SB(1, 1), cB + hstep + kstep, voffB);
        PG8_WAIT_V(6); PG8_BAR;
    } else {
        PG8_STAGE(PG8_SB(0, 0), cB, voffB); PG8_STAGE(PG8_SA(0, 0), cA, voffA); PG8_STAGE(PG8_SB(0, 1), cB + hstep, voffB); PG8_STAGE(PG8_SA(0, 1), cA + hstep, voffA);
        if (wr == 1) PG8_BAR;
        PG8_WAIT_V(4); PG8_BAR;
        PG8_STAGE(PG8_SB(1, 0), cB + kstep, voffB); PG8_STAGE(PG8_SA(1, 0), cA + kstep, voffA); PG8_STAGE(PG8_SB(1, 1), cB + hstep + kstep, voffB);
        PG8_WAIT_V(6); PG8_BAR;
    }
    for (;;) {
        const bool has_next = S.next(ui + 1, nxt);
        const char* nA = has_next ? (const char*)g.A + (size_t)nxt.pm * tstep : cA; const char* nB = has_next ? (const char*)g.Bt + (size_t)nxt.pn * tstep : cB;
        for (int t = 0; t < nt; t += 2) {
            const bool last = (t == nt - 2);
            const char* a1 = cA + (size_t)(t + 1) * kstep;
            const char* a2 = last ? nA : cA + (size_t)(t + 2) * kstep; const char* b2 = last ? nB : cB + (size_t)(t + 2) * kstep;
            const char* a3 = a2 + kstep; const char* b3 = b2 + kstep;
            if (last && has_next) S.a_ready(nxt);
            if constexpr (SP2) {
            PG8_LDB(B0, 0, 0); PG8_LDB(B1, 0, 1); PG8_SCHED; PG8_LDA(At, 0, 0); PG8_STAGE(PG8_SA(1, 1), a1 + hstep, voffA);
            PG8_WAIT_V(8); PG8_WAIT_L(0); PG8_BAR; PG8_MMA(0, 0, At, B0); PG8_MMA(0, 1, At, B1); PG8_BAR; PG8_SCHED;
            PG8_LDA(At, 0, 1); PG8_STAGE(PG8_SB(0, 0), b2, voffB); PG8_STAGE(PG8_SB(0, 1), b2 + hstep, voffB); PG8_STAGE(PG8_SA(0, 0), a2, voffA);
            PG8_WAIT_V(8); PG8_WAIT_L(0); PG8_BAR; PG8_MMA(1, 0, At, B0); PG8_MMA(1, 1, At, B1); PG8_BAR; PG8_SCHED;
            PG8_LDB(B0, 1, 0); PG8_LDB(B1, 1, 1); PG8_SCHED; PG8_LDA(At, 1, 0); PG8_STAGE(PG8_SA(0, 1), a2 + hstep, voffA);
            PG8_WAIT_V(8); PG8_WAIT_L(0); PG8_BAR; PG8_MMA(0, 0, At, B0); PG8_MMA(0, 1, At, B1); PG8_BAR; PG8_SCHED;
            PG8_LDA(At, 1, 1); PG8_STAGE(PG8_SB(1, 0), b3, voffB); PG8_STAGE(PG8_SB(1, 1), b3 + hstep, voffB); PG8_STAGE(PG8_SA(1, 0), a3, voffA);
            PG8_WAIT_V(8); PG8_WAIT_L(0); PG8_BAR; PG8_MMA(1, 0, At, B0); PG8_MMA(1, 1, At, B1); PG8_BAR; PG8_SCHED;
            } else {
            PG8_LDB(B0, 0, 0); PG8_SCHED; PG8_LDA(At, 0, 0); PG8_STAGE(PG8_SA(1, 1), a1 + hstep, voffA);
            PG8_WAIT_L(8); PG8_BAR; PG8_WAIT_L(0); PG8_MMA(0, 0, At, B0); PG8_BAR; PG8_SCHED;
            PG8_LDB(B1, 0, 1); PG8_STAGE(PG8_SB(0, 0), b2, voffB);
            PG8_BAR; PG8_WAIT_L(0); PG8_MMA(0, 1, At, B1); PG8_BAR;
            PG8_LDA(At, 0, 1); PG8_STAGE(PG8_SA(0, 0), a2, voffA);
            PG8_BAR; PG8_WAIT_L(0); PG8_MMA(1, 0, At, B0); PG8_BAR; PG8_SCHED;
            PG8_STAGE(PG8_SB(0, 1), b2 + hstep, voffB);
            PG8_WAIT_V(6); PG8_BAR; PG8_MMA(1, 1, At, B1); PG8_BAR;
            PG8_LDB(B0, 1, 0); PG8_SCHED; PG8_LDA(At, 1, 0); PG8_STAGE(PG8_SA(0, 1), a2 + hstep, voffA);
            PG8_WAIT_L(8); PG8_BAR; PG8_WAIT_L(0); PG8_MMA(0, 0, At, B0); PG8_BAR; PG8_SCHED;
            PG8_LDB(B1, 1, 1); PG8_STAGE(PG8_SB(1, 0), b3, voffB);
            PG8_BAR; PG8_WAIT_L(0); PG8_MMA(0, 1, At, B1); PG8_BAR;
            PG8_LDA(At, 1, 1); PG8_STAGE(PG8_SA(1, 0), a3, voffA);
            PG8_BAR; PG8_WAIT_L(0); PG8_MMA(1, 0, At, B0); PG8_BAR; PG8_SCHED;
            PG8_STAGE(PG8_SB(1, 1), b3 + hstep, voffB);
            PG8_WAIT_V(6); PG8_BAR; PG8_MMA(1, 1, At, B1); PG8_BAR;
            }
        }
        if constexpr (ALIGN_EPI) { if (wr == 0) PG8_BAR; }
        if constexpr (!Epi::AFTER_DRAIN) { E(acc, cur, wr, wc, fr, fq); S.done(cur); }
        if (!has_next) break;
#pragma unroll
        for (int a = 0; a < 2; ++a)
#pragma unroll
            for (int b = 0; b < 2; ++b)
#pragma unroll
                for (int m = 0; m < 4; ++m)
#pragma unroll
                    for (int n = 0; n < 2; ++n) acc[a][b][m][n] = (f32x4){0.f, 0.f, 0.f, 0.f};
        cur = nxt; cA = nA; cB = nB; ++ui;
        if constexpr (ALIGN_EPI) { if (wr == 1) PG8_BAR; }
    }
    PG8_WAIT_V(0);
    if constexpr (!ALIGN_EPI) { if (wr == 0) PG8_BAR; }
    PG8_BAR;
    if constexpr (Epi::AFTER_DRAIN) { E.fused(acc, cur, wr, wc, fr, fq, lds, wid, lane); S.done(cur); }
#undef PG8_SA
#undef PG8_SB
#undef PG8_STAGE
#undef PG8_LDA
#undef PG8_LDB
#undef PG8_MMA
#undef PG8_WAIT_V
#undef PG8_WAIT_L
#undef PG8_BAR
#undef PG8_SCHED
}
}
#define GAS __attribute__((address_space(1)))
#define LAS __attribute__((address_space(3)))
typedef unsigned short bf16;
typedef unsigned v4u __attribute__((ext_vector_type(4)));
typedef float f32x4 __attribute__((ext_vector_type(4)));
typedef short bf16x8 __attribute__((ext_vector_type(8)));
typedef GAS unsigned gu32;
typedef GAS unsigned long long gu64;
#define RLX_AGENT __ATOMIC_RELAXED, __HIP_MEMORY_SCOPE_AGENT
#define LDS_WAIT() asm volatile("s_waitcnt lgkmcnt(0)" ::: "memory")
#define VM_WAIT() asm volatile("s_waitcnt vmcnt(0)" ::: "memory")
__device__ __forceinline__ unsigned long long rt() { return __builtin_amdgcn_s_memrealtime(); }
__device__ __forceinline__ unsigned f2bf(float f) { unsigned u = __builtin_bit_cast(unsigned, f); return (u + 0x7fffu + ((u >> 16) & 1u)) >> 16; }
__device__ __forceinline__ unsigned pk2(float lo, float hi) { return f2bf(lo) | (f2bf(hi) << 16); }

#define XB_TMO      128
#define XB_XCNT(j)  (256  + 64 * (j))
#define XB_XSUB(j)  (1280 + 64 * (j))
#define XB_XGEN(j)  (2304 + 64 * (j))
#define XB_TOP      3328
#define XB_TOPGEN   3392
#define XCD_BAR_WORDS 3456
#define XB_SPIN_CAP (1u << 18)

__device__ __forceinline__ unsigned xb_ld(unsigned* p)              { return __hip_atomic_load(p, __ATOMIC_RELAXED, __HIP_MEMORY_SCOPE_AGENT); }
__device__ __forceinline__ unsigned xb_add(unsigned* p, unsigned v) { return __hip_atomic_fetch_add(p, v, __ATOMIC_RELAXED, __HIP_MEMORY_SCOPE_AGENT); }
__device__ __forceinline__ unsigned xb_xcc_id() { return (unsigned)__builtin_amdgcn_s_getreg((3 << 11) | 20) & 0xFu; }
#define XB_SPIN(cond, bar) do { unsigned _sp = 0; while (cond) { __builtin_amdgcn_s_sleep(1); \
    if ((++_sp & 255u) == 0u) { if (xb_ld(&(bar)[XB_TMO])) break; if (_sp > XB_SPIN_CAP) { atomicAdd(&(bar)[XB_TMO], 1u); break; } } } } while (0)

struct XcdBarrier {
    unsigned* bar; unsigned x;
    volatile LAS unsigned* st;
};

__device__ __forceinline__ XcdBarrier xcd_barrier_post(unsigned* bar, volatile LAS unsigned* st) {
    XcdBarrier b; b.bar = bar; b.x = xb_xcc_id(); b.st = st;
    if (threadIdx.x == 0) (void)xb_add(&bar[XB_XCNT(b.x)], 1u);
    return b;
}
__device__ __forceinline__ void xcd_barrier_complete(unsigned* bar, unsigned x, unsigned& nloc, unsigned& nx) {
    const unsigned G = gridDim.x * gridDim.y * gridDim.z;
    unsigned sum, cnt, mine, sp = 0u;
    for (;;) {
        sum = 0u; cnt = 0u; mine = 0u;
#pragma unroll
        for (unsigned j = 0; j < 16; ++j) { const unsigned c = xb_ld(&bar[XB_XCNT(j)]); sum += c; cnt += (c > 0u) ? 1u : 0u; mine = (j == x) ? c : mine; }
        if (sum == G) break;
        __builtin_amdgcn_s_sleep(1);
        if ((++sp & 255u) == 0u) { if (xb_ld(&bar[XB_TMO])) break; if (sp > XB_SPIN_CAP) { atomicAdd(&bar[XB_TMO], 1u); break; } }
    }
    nloc = mine > 0u ? mine : 1u; nx = cnt > 0u ? cnt : 1u;
}

__device__ __forceinline__ void xcd_barrier(const XcdBarrier& b) {
    asm volatile("s_waitcnt vmcnt(0)" ::: "memory");
    __syncthreads();
    if (threadIdx.x == 0) {
        unsigned* bar = b.bar;
        __builtin_amdgcn_s_waitcnt(0);
        unsigned nloc = b.st[0], nx = b.st[1];
        if (nloc == 0u) { xcd_barrier_complete(bar, b.x, nloc, nx); b.st[0] = nloc; b.st[1] = nx; }
        const unsigned old = xb_add(&bar[XB_XSUB(b.x)], 1u);
        const unsigned gen = old / nloc;
        if (old + 1u == (gen + 1u) * nloc) {
            __builtin_amdgcn_fence(__ATOMIC_RELEASE, "agent");
            asm volatile("s_waitcnt vmcnt(0)" ::: "memory");
            const unsigned og = xb_add(&bar[XB_TOP], 1u);
            const unsigned tg = og / nx;
            if (og + 1u == (tg + 1u) * nx) xb_add(&bar[XB_TOPGEN], 1u);
            else XB_SPIN(xb_ld(&bar[XB_TOPGEN]) == tg, bar);
            __builtin_amdgcn_fence(__ATOMIC_ACQUIRE, "agent");
            xb_add(&bar[XB_XGEN(b.x)], 1u);
            asm volatile("s_waitcnt vmcnt(0)" ::: "memory");
        } else {
            XB_SPIN(xb_ld(&bar[XB_XGEN(b.x)]) == gen, bar);
            __builtin_amdgcn_fence(__ATOMIC_ACQUIRE, "agent");
            asm volatile("s_waitcnt vmcnt(0)" ::: "memory");
        }
    }
    __syncthreads();
}
constexpr int D = 1024, BATCH = 16, SEQ = 2048, M = BATCH * SEQ, DFF = 2816, WA = 512, CHUNK = 128, CONVK = 31, NMOD = 9, NADA = NMOD * D;
constexpr float EPS = 1e-6f;
constexpr int NWAVES = 8;
constexpr size_t MiB = 1u << 20;
constexpr size_t WS_CTL = 0, CTL_ZERO_BYTES = 1 * MiB;
constexpr size_t WS_ADA = 1 * MiB;
constexpr size_t WS_W1 = 2 * MiB, WS_W2 = 13 * MiB, WS_W3 = 19 * MiB, WS_W4 = 23 * MiB, WS_W5 = 25 * MiB, WS_W6 = 36 * MiB;
constexpr size_t WS_H = 48 * MiB;
constexpr size_t WS_HID = 112 * MiB;
constexpr size_t WS_U = WS_HID, WS_V = WS_HID + 32 * MiB, WS_GLU = WS_HID + 64 * MiB, WS_VLN = WS_HID + 96 * MiB;
constexpr size_t WS_Y = 288 * MiB;
constexpr size_t WS_F = 352 * MiB;
constexpr size_t WS_END = 480 * MiB;
static_assert(WS_W6 + (size_t)D * DFF * 2 <= WS_H && WS_HID + (size_t)M * DFF * 2 <= WS_Y && WS_Y + (size_t)M * D * 2 <= WS_F && WS_F + (size_t)M * D * 4 <= WS_END, "d_ws map");
constexpr int CW_BAR = 4096;
constexpr int LDS_BYTES = 163840, LDSCTL_OFF = LDS_BYTES - 512, MISC_OFF = LDSCTL_OFF;

struct Frame {
    LAS unsigned char* lds;
    volatile LAS unsigned* MISC;
    int tid, lane, wave, vcu, G;
};
__device__ __forceinline__ float bf2f(unsigned h) { return __uint_as_float(h << 16); }
__device__ __forceinline__ float wave_sum(float v) {
#pragma unroll
    for (int o = 1; o < 64; o <<= 1) v += __shfl_xor(v, o);
    return v;
}
__device__ __forceinline__ float silu_f(float v) { return v / (1.f + __expf(-v)); }

__device__ __forceinline__ void phase_ada(Frame& F, const float* c, const float* w_ada, const float* b_ada, float* ada) {
    LAS float* sc = (LAS float*)F.lds;
    LAS float* red = (LAS float*)(F.lds + 65536);
    if (F.vcu >= NADA / 64) return;
    for (int i = F.tid; i < 16 * 1024; i += 512) { const int b = i >> 10, k = i & 1023; sc[k * 16 + b] = silu_f(c[i]); }
    __syncthreads();
    for (int item = F.vcu; item < NADA / 64; item += F.G) {
        const int col = item * 64 + F.lane, k0 = F.wave * 128;
        float acc[16];
#pragma unroll
        for (int b = 0; b < 16; ++b) acc[b] = 0.f;
        for (int k = k0; k < k0 + 128; ++k) {
            const float wv = w_ada[(size_t)k * NADA + col];
#pragma unroll
            for (int q = 0; q < 4; ++q) { const f32x4 s = *(const LAS f32x4*)&sc[k * 16 + 4 * q];
                acc[4 * q + 0] += s.x * wv; acc[4 * q + 1] += s.y * wv; acc[4 * q + 2] += s.z * wv; acc[4 * q + 3] += s.w * wv; }
        }
#pragma unroll
        for (int b = 0; b < 16; ++b) red[(F.wave * 16 + b) * 64 + F.lane] = acc[b];
        __syncthreads();
        for (int o = F.tid; o < 1024; o += 512) { const int b = o >> 6, l = o & 63; float s = 0.f;
#pragma unroll
            for (int w = 0; w < 8; ++w) s += red[(w * 16 + b) * 64 + l];
            ada[b * NADA + item * 64 + l] = s + b_ada[item * 64 + l]; }
        __syncthreads();
    }
}
__device__ __forceinline__ int dest_row(int mode, int n0) {
    if (mode == 1) { const int up = n0 >= DFF, j = up ? n0 - DFF : n0; return 256 * (j >> 7) + (up ? 128 : 0) + (j & 127); }
    if (mode == 2) { if (n0 < 1024) return n0; const int g = n0 >= 1536, j = n0 - (g ? 1536 : 1024); return 1024 + 256 * (j >> 7) + (g ? 128 : 0) + (j & 127); }
    return n0;
}
__device__ __forceinline__ void transpose_item(const float* W, int K, int N, bf16* WT, int mode, LAS float* scr, int item, int lane) {
    const int nblk = N / 32, kb = item / nblk, nb = item % nblk, k0 = 64 * kb, n0 = 32 * nb, d0 = dest_row(mode, n0);
#pragma unroll 8
    for (int i = 0; i < 32; ++i) { const int kk = 2 * i + (lane >> 5); scr[kk * 33 + (lane & 31)] = W[(size_t)(k0 + kk) * N + n0 + (lane & 31)]; }
    LDS_WAIT(); asm volatile("" ::: "memory");
    const int c = lane & 7;
#pragma unroll
    for (int j = 0; j < 4; ++j) { const int n = (lane >> 3) + 8 * j; const LAS float* s = scr + (8 * c) * 33 + n;
        v4u o; o.x = pk2(s[0 * 33], s[1 * 33]); o.y = pk2(s[2 * 33], s[3 * 33]); o.z = pk2(s[4 * 33], s[5 * 33]); o.w = pk2(s[6 * 33], s[7 * 33]);
        *(GAS v4u*)(WT + (size_t)(d0 + n) * K + k0 + 8 * c) = o; }
    LDS_WAIT(); asm volatile("" ::: "memory");
}
struct WSet { const float *w1, *w2, *w3, *w4, *w5, *w6; bf16 *t1, *t2, *t3, *t4, *t5, *t6; };
__device__ __forceinline__ void phase_wconv(Frame& F, const WSet& w) {
    LAS float* scr = (LAS float*)(F.lds + 98304 + F.wave * 8192 * 0) ;
    scr = (LAS float*)(F.lds + F.wave * 16384);
    const int gw = F.vcu * NWAVES + F.wave, NGW = F.G * NWAVES;
    constexpr int I_1 = (D / 64) * (2 * DFF / 32), I_2 = (DFF / 64) * (D / 32), I_3 = (D / 64) * (4 * WA / 32), I_4 = (D / 64) * (D / 32);
    constexpr int NITEMS = 2 * I_1 + 2 * I_2 + I_3 + I_4;
    for (int it = gw; it < NITEMS; it += NGW) {
        int r = it;
        if (r < I_1) { transpose_item(w.w1, D, 2 * DFF, w.t1, 1, scr, r, F.lane); continue; } r -= I_1;
        if (r < I_2) { transpose_item(w.w2, DFF, D, w.t2, 0, scr, r, F.lane); continue; } r -= I_2;
        if (r < I_3) { transpose_item(w.w3, D, 4 * WA, w.t3, 2, scr, r, F.lane); continue; } r -= I_3;
        if (r < I_4) { transpose_item(w.w4, D, D, w.t4, 0, scr, r, F.lane); continue; } r -= I_4;
        if (r < I_1) { transpose_item(w.w5, D, 2 * DFF, w.t5, 1, scr, r, F.lane); continue; } r -= I_1;
        transpose_item(w.w6, DFF, D, w.t6, 0, scr, r, F.lane);
    }
}
struct EArgs { const float* xin; const float* f; float* xout; bf16* hout; const float* gpost; const float* gt; const float* gpre; const float* sc; const float* sh; float coef; };
__device__ __forceinline__ void phase_rowpass(Frame& F, const EArgs a) {
    const int lane = F.lane, gw = F.vcu * NWAVES + F.wave, ngw = F.G * NWAVES;
    for (int row = gw; row < M; row += ngw) {
        const int b = row / SEQ;
        f32x4 x[4];
#pragma unroll
        for (int j = 0; j < 4; ++j) x[j] = *(const f32x4*)(a.xin + (size_t)row * D + 4 * lane + 256 * j);
        if (a.f) {
            f32x4 f[4]; float ss = 0.f;
#pragma unroll
            for (int j = 0; j < 4; ++j) { f[j] = *(const f32x4*)(a.f + (size_t)row * D + 4 * lane + 256 * j); ss += f[j].x * f[j].x + f[j].y * f[j].y + f[j].z * f[j].z + f[j].w * f[j].w; }
            const float rstd = rsqrtf(wave_sum(ss) * (1.f / D) + EPS);
#pragma unroll
            for (int j = 0; j < 4; ++j) { const int col = 4 * lane + 256 * j; const f32x4 g = *(const f32x4*)(a.gpost + col), t = *(const f32x4*)(a.gt + (size_t)b * NADA + col);
                x[j] = x[j] + (t * a.coef) * (f[j] * rstd * g);
                *(f32x4*)(a.xout + (size_t)row * D + col) = x[j]; }
        }
        if (a.hout) {
            float ss = 0.f;
#pragma unroll
            for (int j = 0; j < 4; ++j) ss += x[j].x * x[j].x + x[j].y * x[j].y + x[j].z * x[j].z + x[j].w * x[j].w;
            const float rstd = rsqrtf(wave_sum(ss) * (1.f / D) + EPS);
#pragma unroll
            for (int j = 0; j < 4; ++j) { const int col = 4 * lane + 256 * j; const f32x4 g = *(const f32x4*)(a.gpre + col), s = *(const f32x4*)(a.sc + (size_t)b * NADA + col), h = *(const f32x4*)(a.sh + (size_t)b * NADA + col);
                const f32x4 o = x[j] * rstd * g * (s + 1.0f) + h;
                uint2 w; w.x = pk2(o.x, o.y); w.y = pk2(o.z, o.w); *(uint2*)(a.hout + (size_t)row * D + col) = w; }
        }
    }
}
__device__ __forceinline__ void phase_lnv(Frame& F, const bf16* V, const float* g, const float* bta, bf16* VLN) {
    const int lane = F.lane, gw = F.vcu * NWAVES + F.wave, ngw = F.G * NWAVES;
    for (int row = gw; row < M; row += ngw) {
        const uint4 w = *(const uint4*)(V + (size_t)row * WA + 8 * lane);
        float v[8] = {bf2f(w.x & 0xffffu), bf2f(w.x >> 16), bf2f(w.y & 0xffffu), bf2f(w.y >> 16), bf2f(w.z & 0xffffu), bf2f(w.z >> 16), bf2f(w.w & 0xffffu), bf2f(w.w >> 16)};
        float s = 0.f;
#pragma unroll
        for (int i = 0; i < 8; ++i) s += v[i];
        const float mu = wave_sum(s) * (1.f / WA); float q = 0.f;
#pragma unroll
        for (int i = 0; i < 8; ++i) { v[i] -= mu; q += v[i] * v[i]; }
        const float rstd = rsqrtf(wave_sum(q) * (1.f / WA) + EPS);
        float o[8];
#pragma unroll
        for (int i = 0; i < 8; ++i) o[i] = v[i] * rstd * g[8 * lane + i] + bta[8 * lane + i];
        uint4 r; r.x = pk2(o[0], o[1]); r.y = pk2(o[2], o[3]); r.z = pk2(o[4], o[5]); r.w = pk2(o[6], o[7]);
        *(uint4*)(VLN + (size_t)row * WA + 8 * lane) = r;
    }
}
__device__ __forceinline__ void phase_gmlp_conv(Frame& F, const bf16* U, const bf16* VLN, const float* wsp, const float* bsp, float* YA, const bf16* GLU, const float* cw, const float* cb, float* CV) {
    const int col = F.tid;
    for (int row = F.vcu; row < M; row += F.G) {
        const int t = row & (CHUNK - 1), h = col >> 6, r0 = row - t;
        const float* w = wsp + ((size_t)h * CHUNK + t) * CHUNK;
        float z = 0.f;
        for (int s = 0; s <= t; ++s) z += w[s] * bf2f(VLN[(size_t)(r0 + s) * WA + col]);
        z += bsp[h * CHUNK + t];
        YA[(size_t)row * WA + col] = bf2f(U[(size_t)row * WA + col]) * z;
        const int p = row % SEQ; float s2 = 0.f;
#pragma unroll
        for (int j = 0; j < CONVK; ++j) { const int pp = p - (CONVK - 1) + j; if (pp >= 0) s2 += cw[j * WA + col] * bf2f(GLU[(size_t)(row - (CONVK - 1) + j) * WA + col]); }
        CV[(size_t)row * WA + col] = s2 + cb[col];
    }
}
__device__ __forceinline__ void phase_mixnorm(Frame& F, const float* YA, const float* CV, const float* cng, const float* cnb, const float* goa, const float* gob, bf16* Y) {
    const int lane = F.lane, gw = F.vcu * NWAVES + F.wave, ngw = F.G * NWAVES;
    for (int row = gw; row < M; row += ngw) {
        float a[8], c[8];
#pragma unroll
        for (int q = 0; q < 2; ++q) { const f32x4 t = *(const f32x4*)(YA + (size_t)row * WA + 8 * lane + 4 * q); a[4 * q] = t.x; a[4 * q + 1] = t.y; a[4 * q + 2] = t.z; a[4 * q + 3] = t.w;
            const f32x4 u = *(const f32x4*)(CV + (size_t)row * WA + 8 * lane + 4 * q); c[4 * q] = u.x; c[4 * q + 1] = u.y; c[4 * q + 2] = u.z; c[4 * q + 3] = u.w; }
        float sa = 0.f, sc = 0.f;
#pragma unroll
        for (int i = 0; i < 8; ++i) { sa += a[i] * a[i]; sc += c[i]; }
        const float ra = rsqrtf(wave_sum(sa) * (1.f / WA) + EPS), mu = wave_sum(sc) * (1.f / WA);
        float q = 0.f;
#pragma unroll
        for (int i = 0; i < 8; ++i) { c[i] -= mu; q += c[i] * c[i]; }
        const float rc = rsqrtf(wave_sum(q) * (1.f / WA) + EPS);
        float sb = 0.f;
#pragma unroll
        for (int i = 0; i < 8; ++i) { c[i] = silu_f(c[i] * rc * cng[8 * lane + i] + cnb[8 * lane + i]); sb += c[i] * c[i]; }
        const float rb = rsqrtf(wave_sum(sb) * (1.f / WA) + EPS);
        float oa[8], ob[8];
#pragma unroll
        for (int i = 0; i < 8; ++i) { oa[i] = a[i] * ra * goa[8 * lane + i]; ob[i] = c[i] * rb * gob[8 * lane + i]; }
        uint4 r; r.x = pk2(oa[0], oa[1]); r.y = pk2(oa[2], oa[3]); r.z = pk2(oa[4], oa[5]); r.w = pk2(oa[6], oa[7]);
        *(uint4*)(Y + (size_t)row * D + 8 * lane) = r;
        r.x = pk2(ob[0], ob[1]); r.y = pk2(ob[2], ob[3]); r.z = pk2(ob[4], ob[5]); r.w = pk2(ob[6], ob[7]);
        *(uint4*)(Y + (size_t)row * D + WA + 8 * lane) = r;
    }
}
#ifndef MK_PER_PHASE
#define MK_PER_PHASE 0
#endif
constexpr int N_PHASES = 14;
struct Args { const float* in[26]; float* out; unsigned char* ws; int ph_lo, ph_hi; };
__global__ void __launch_bounds__(NWAVES * 64, 2) mk_fwd(Args args) {
    extern __shared__ __attribute__((aligned(16))) unsigned char lds[];
    Frame F;
    F.lds = (LAS unsigned char*)lds;
    F.MISC = (volatile LAS unsigned*)(F.lds + MISC_OFF);
    F.tid = threadIdx.x; F.lane = F.tid & 63; F.wave = __builtin_amdgcn_readfirstlane(F.tid >> 6);
    F.G = gridDim.x; { const int bx = blockIdx.x; F.vcu = (F.G % 8 == 0) ? (bx % 8) * (F.G / 8) + bx / 8 : bx; }
    unsigned char* ws = args.ws;
    gu32* ctl = (gu32*)(ws + WS_CTL);
    for (int u = F.tid; u < (LDS_BYTES - LDSCTL_OFF) / 4; u += NWAVES * 64) ((LAS unsigned*)(F.lds + LDSCTL_OFF))[u] = 0u;
    __syncthreads();
    XcdBarrier bar = xcd_barrier_post((unsigned*)(ctl + CW_BAR), F.MISC + 8);
    const int lo = args.ph_lo, hi = args.ph_hi;
#define IN(k) (lo <= (k) && (k) < hi)
#define SEAM(k) do { if (IN(k) && IN((k) + 1)) xcd_barrier(bar); } while (0)
    const float *x = args.in[0], *c = args.in[1], *w_ada = args.in[2], *b_ada = args.in[3], *g_pre_f1 = args.in[4], *g_post_f1 = args.in[5], *g_pre_m = args.in[8], *g_post_m = args.in[9],
                *gmlp_g = args.in[11], *gmlp_b = args.in[12], *w_sp = args.in[13], *b_sp = args.in[14], *conv_w = args.in[15], *conv_b = args.in[16], *cn_g = args.in[17], *cn_b = args.in[18],
                *g_out_a = args.in[19], *g_out_b = args.in[20], *g_pre_f2 = args.in[22], *g_post_f2 = args.in[23];
    float* out = args.out;
    float* ada = (float*)(ws + WS_ADA); bf16* H = (bf16*)(ws + WS_H); bf16* HID = (bf16*)(ws + WS_HID); bf16* Y = (bf16*)(ws + WS_Y); float* Fb = (float*)(ws + WS_F);
    bf16 *U = (bf16*)(ws + WS_U), *V = (bf16*)(ws + WS_V), *GLU = (bf16*)(ws + WS_GLU), *VLN = (bf16*)(ws + WS_VLN);
    bf16 *W1 = (bf16*)(ws + WS_W1), *W2 = (bf16*)(ws + WS_W2), *W3 = (bf16*)(ws + WS_W3), *W4 = (bf16*)(ws + WS_W4), *W5 = (bf16*)(ws + WS_W5), *W6 = (bf16*)(ws + WS_W6);
    float *YA = Fb, *CV = Fb + (size_t)M * WA;
    const float *sh1 = ada, *sc1 = ada + D, *gt1 = ada + 2 * D, *sh2 = ada + 3 * D, *sc2 = ada + 4 * D, *gt2 = ada + 5 * D, *sh3 = ada + 6 * D, *sc3 = ada + 7 * D, *gt3 = ada + 8 * D;

    if (IN(0)) { phase_ada(F, c, w_ada, b_ada, ada); __syncthreads();
                 phase_wconv(F, WSet{args.in[6], args.in[7], args.in[10], args.in[21], args.in[24], args.in[25], W1, W2, W3, W4, W5, W6}); }
    SEAM(0);
    if (IN(1)) phase_rowpass(F, EArgs{x, nullptr, nullptr, H, nullptr, nullptr, g_pre_f1, sc1, sh1, 0.f});
    SEAM(1);
    if (IN(2)) { pg8::Gemm g{H, W1, M, 2 * DFF, D}; pg8::StaticOrder S; S.init(M, 2 * DFF, F.G, (int)blockIdx.x); pg8::EpiSwiglu E{HID, DFF};
                 pg8::gemm_phase<pg8::EpiSwiglu, pg8::StaticOrder, true, true>(F.lds, g, S, E); }
    SEAM(2);
    if (IN(3)) { pg8::Gemm g{HID, W2, M, D, DFF}; pg8::StaticOrder S; S.init(M, D, F.G, (int)blockIdx.x); pg8::EpiF32 E{Fb, D};
                 pg8::gemm_phase<pg8::EpiF32, pg8::StaticOrder, true, true>(F.lds, g, S, E); }
    SEAM(3);
    if (IN(4)) phase_rowpass(F, EArgs{x, Fb, out, H, g_post_f1, gt1, g_pre_m, sc2, sh2, 0.5f});
    SEAM(4);
    if (IN(5)) { pg8::Gemm g{H, W3, M, 4 * WA, D}; pg8::StaticOrder S; S.init(M, 4 * WA, F.G, (int)blockIdx.x); pg8::EpiMixIn E{U, V, GLU};
                 pg8::gemm_phase<pg8::EpiMixIn, pg8::StaticOrder, true, true>(F.lds, g, S, E); }
    SEAM(5);
    if (IN(6)) phase_lnv(F, V, gmlp_g, gmlp_b, VLN);
    SEAM(6);
    if (IN(7)) phase_gmlp_conv(F, U, VLN, w_sp, b_sp, YA, GLU, conv_w, conv_b, CV);
    SEAM(7);
    if (IN(8)) phase_mixnorm(F, YA, CV, cn_g, cn_b, g_out_a, g_out_b, Y);
    SEAM(8);
    if (IN(9)) { pg8::Gemm g{Y, W4, M, D, D}; pg8::StaticOrder S; S.init(M, D, F.G, (int)blockIdx.x); pg8::EpiF32 E{Fb, D};
                 pg8::gemm_phase<pg8::EpiF32, pg8::StaticOrder, true, true>(F.lds, g, S, E); }
    SEAM(9);
    if (IN(10)) phase_rowpass(F, EArgs{out, Fb, out, H, g_post_m, gt2, g_pre_f2, sc3, sh3, 1.0f});
    SEAM(10);
    if (IN(11)) { pg8::Gemm g{H, W5, M, 2 * DFF, D}; pg8::StaticOrder S; S.init(M, 2 * DFF, F.G, (int)blockIdx.x); pg8::EpiSwiglu E{HID, DFF};
                  pg8::gemm_phase<pg8::EpiSwiglu, pg8::StaticOrder, true, true>(F.lds, g, S, E); }
    SEAM(11);
    if (IN(12)) { pg8::Gemm g{HID, W6, M, D, DFF}; pg8::StaticOrder S; S.init(M, D, F.G, (int)blockIdx.x); pg8::EpiF32 E{Fb, D};
                  pg8::gemm_phase<pg8::EpiF32, pg8::StaticOrder, true, true>(F.lds, g, S, E); }
    SEAM(12);
    if (IN(13)) phase_rowpass(F, EArgs{out, Fb, out, nullptr, g_post_f2, gt3, nullptr, nullptr, nullptr, 0.5f});
#undef IN
#undef SEAM
}

extern "C" void kernel_launch(void* const* d_in, const int* in_sizes, int n_in, void* d_out, int out_size, void* d_ws, size_t ws_size, hipStream_t stream) {
    static int grid = 0;
    if (grid == 0) {
        if (n_in != 26 || in_sizes[0] != M * D || out_size != M * D || ws_size < WS_END) { fprintf(stderr, "kernel_launch: unexpected shapes (n_in %d, in0 %d, out %d, ws %zu)\n", n_in, n_in > 0 ? in_sizes[0] : -1, out_size, ws_size); grid = -1; return; }
        int dev = 0, cus = 0, per_cu = 0;
        if (hipGetDevice(&dev) != hipSuccess || hipDeviceGetAttribute(&cus, hipDeviceAttributeMultiprocessorCount, dev) != hipSuccess) { fprintf(stderr, "kernel_launch: device query failed\n"); grid = -1; return; }
        if (hipFuncSetAttribute((const void*)mk_fwd, hipFuncAttributeMaxDynamicSharedMemorySize, LDS_BYTES) != hipSuccess) { fprintf(stderr, "kernel_launch: hipFuncSetAttribute failed\n"); grid = -1; return; }
        if (hipOccupancyMaxActiveBlocksPerMultiprocessor(&per_cu, (const void*)mk_fwd, NWAVES * 64, LDS_BYTES) != hipSuccess || per_cu < 1) fprintf(stderr, "kernel_launch: note: occupancy query reports %d workgroups per CU\n", per_cu);
        (void)hipGetLastError();
        grid = cus;
    }
    if (grid < 0) return;
    if (hipMemsetAsync((char*)d_ws + WS_CTL, 0, CTL_ZERO_BYTES, stream) != hipSuccess) { fprintf(stderr, "kernel_launch: memset failed\n"); return; }
    Args a{};
    for (int i = 0; i < 26; ++i) a.in[i] = (const float*)d_in[i];
    a.out = (float*)d_out; a.ws = (unsigned char*)d_ws;
#if MK_PER_PHASE
    for (int p = 0; p < N_PHASES; ++p) { a.ph_lo = p; a.ph_hi = p + 1; hipLaunchKernelGGL(mk_fwd, dim3(grid), dim3(NWAVES * 64), LDS_BYTES, stream, a); }
#else
    a.ph_lo = 0; a.ph_hi = N_PHASES;
    hipLaunchKernelGGL(mk_fwd, dim3(grid), dim3(NWAVES * 64), LDS_BYTES, stream, a);
#endif
    const hipError_t le = hipPeekAtLastError();
    if (le != hipSuccess) fprintf(stderr, "kernel_launch: launch failed: %s (grid %d)\n", hipGetErrorName(le), grid);
}
```

```cpp
#include <hip/hip_runtime.h>
#include <cstdio>
#include <cstdint>
namespace pg8 {
#define PG8_LAS __attribute__((address_space(3)))
typedef unsigned short bf16_t;
typedef short bf16x8 __attribute__((ext_vector_type(8)));
typedef float f32x4 __attribute__((ext_vector_type(4)));
typedef unsigned u32x4 __attribute__((ext_vector_type(4)));
constexpr int BM = 256, BK = 64, HALF = 128, HTB = HALF * BK * 2  , STAGE_BYTES = 8 * HTB, NXCD = 8, WGM = 8;

__host__ __device__ __forceinline__ int lds_byte(int r, int c) { const int st = (r >> 4) * 2 + (c >> 5), rr = r & 15, cc = c & 31, ob = rr * 64 + cc * 2; return st * 1024 + (ob ^ (((ob >> 9) & 1) << 5)); }
__host__ __device__ __forceinline__ void stage_rc(int b, int& R, int& C) { const int st = b / 1024, sb = b % 1024, swz = sb ^ (((sb >> 9) & 1) << 5); R = (st >> 1) * 16 + swz / 64; C = (st & 1) * 32 + (swz % 64) / 2; }
__host__ __device__ __forceinline__ int perm32(int rho) { const int n = rho >> 4, i = rho & 15; return 8 * (i >> 2) + 4 * n + (i & 3); }

struct Unit { int pm, pn; };
struct Gemm { const bf16_t* A; const bf16_t* Bt; int M, N, K; };

struct StaticOrder {
    int nM, nN, nwg, G, c;
    __host__ __device__ void init(int M, int N, int G_, int c_) { nM = M / BM; nN = N / BM; nwg = nM * nN; G = G_; c = c_; }
    __host__ __device__ bool next(int i, Unit& u) const {
        const long L = (long)i * G + c; if (L >= nwg) return false;
        int wgid = (int)L; { const int q = nwg / NXCD, r = nwg % NXCD, xcd = wgid % NXCD, off = wgid / NXCD; wgid = (xcd < r ? xcd * (q + 1) : r * (q + 1) + (xcd - r) * q) + off; }
        const int nig = WGM * nN, gid = wgid / nig, fm = gid * WGM, gsz = (nM - fm) < WGM ? (nM - fm) : WGM;
        u.pm = fm + ((wgid % nig) % gsz); u.pn = (wgid % nig) / gsz; return true;
    }
    __device__ __forceinline__ void a_ready(const Unit&) const {}
    __device__ __forceinline__ void done(const Unit&) const {}
};
__device__ __forceinline__ unsigned cvt_pk_bf16(float lo, float hi) { unsigned r; asm volatile("v_cvt_pk_bf16_f32 %0, %1, %2" : "=v"(r) : "v"(lo), "v"(hi)); return r; }
typedef float f32x2 __attribute__((ext_vector_type(2)));
__device__ __forceinline__ float fast_sigmoid(float v) { return __builtin_amdgcn_rcpf(1.0f + __builtin_amdgcn_exp2f(v * -1.4426950408889634f)); }
struct EpiF32 {
    static constexpr bool PERM = false, AFTER_DRAIN = false;
    float* C; int ldc;
    __device__ __forceinline__ void operator()(const f32x4 (&acc)[2][2][4][2], const Unit& u, int wr, int wc, int fr, int fq) const {
        const int row0 = u.pm * BM + wr * 64 + fr, col0 = u.pn * BM + wc * 32 + 4 * fq;
#pragma unroll
        for (int ai = 0; ai < 2; ++ai)
#pragma unroll
            for (int m = 0; m < 4; ++m) { float* rowp = C + (size_t)(row0 + ai * HALF + m * 16) * ldc + col0;
#pragma unroll
                for (int bj = 0; bj < 2; ++bj)
#pragma unroll
                    for (int n = 0; n < 2; ++n) *(f32x4*)(rowp + bj * HALF + n * 16) = acc[ai][bj][m][n]; }
    }
};
struct EpiSwiglu {
    static constexpr bool PERM = true, AFTER_DRAIN = false;
    bf16_t* O; int ldc;
    __device__ __forceinline__ void operator()(const f32x4 (&acc)[2][2][4][2], const Unit& u, int wr, int wc, int fr, int fq) const {
        const int row0 = u.pm * BM + wr * 64 + fr, col0 = u.pn * HALF + wc * 32 + 8 * fq;
#pragma unroll
        for (int ai = 0; ai < 2; ++ai)
#pragma unroll
            for (int m = 0; m < 4; ++m) { bf16_t* rowp = O + (size_t)(row0 + ai * HALF + m * 16) * ldc + col0;
                float h[8];
#pragma unroll
                for (int n = 0; n < 2; ++n)
#pragma unroll
                    for (int e = 0; e < 4; ++e) { const float g = acc[ai][0][m][n][e], up = acc[ai][1][m][n][e]; h[4 * n + e] = g * fast_sigmoid(g) * up; }
                u32x4 w; w.x = cvt_pk_bf16(h[0], h[1]); w.y = cvt_pk_bf16(h[2], h[3]); w.z = cvt_pk_bf16(h[4], h[5]); w.w = cvt_pk_bf16(h[6], h[7]);
                *(u32x4*)rowp = w; }
    }
};
struct EpiMixIn {
    static constexpr bool PERM = true, AFTER_DRAIN = false;
    bf16_t* U; bf16_t* V; bf16_t* G;
    __device__ __forceinline__ void operator()(const f32x4 (&acc)[2][2][4][2], const Unit& u, int wr, int wc, int fr, int fq) const {
        const int row0 = u.pm * BM + wr * 64 + fr;
        if (u.pn < 4) {
            bf16_t* dst = (u.pn < 2 ? U : V) + (u.pn & 1) * BM + wc * 32 + 8 * fq;
#pragma unroll
            for (int ai = 0; ai < 2; ++ai)
#pragma unroll
                for (int m = 0; m < 4; ++m) { bf16_t* rowp = dst + (size_t)(row0 + ai * HALF + m * 16) * 512;
#pragma unroll
                    for (int bj = 0; bj < 2; ++bj) { const f32x4 v0 = acc[ai][bj][m][0], v1 = acc[ai][bj][m][1];
                        u32x4 w; w.x = cvt_pk_bf16(v0[0], v0[1]); w.y = cvt_pk_bf16(v0[2], v0[3]); w.z = cvt_pk_bf16(v1[0], v1[1]); w.w = cvt_pk_bf16(v1[2], v1[3]);
                        *(u32x4*)(rowp + bj * HALF) = w; } }
        } else {
            bf16_t* dst = G + (u.pn - 4) * HALF + wc * 32 + 8 * fq;
#pragma unroll
            for (int ai = 0; ai < 2; ++ai)
#pragma unroll
                for (int m = 0; m < 4; ++m) { bf16_t* rowp = dst + (size_t)(row0 + ai * HALF + m * 16) * 512;
                    float h[8];
#pragma unroll
                    for (int n = 0; n < 2; ++n)
#pragma unroll
                        for (int e = 0; e < 4; ++e) h[4 * n + e] = acc[ai][0][m][n][e] * fast_sigmoid(acc[ai][1][m][n][e]);
                    u32x4 w; w.x = cvt_pk_bf16(h[0], h[1]); w.y = cvt_pk_bf16(h[2], h[3]); w.z = cvt_pk_bf16(h[4], h[5]); w.w = cvt_pk_bf16(h[6], h[7]);
                    *(u32x4*)rowp = w; }
        }
    }
};
template <class Epi, class Sched, bool ALIGN_EPI = false, bool SP2 = false>
__device__ __forceinline__ void gemm_phase(PG8_LAS unsigned char* lds, const Gemm g, const Sched& S, const Epi& E) {
    const int tid = threadIdx.x, wid = __builtin_amdgcn_readfirstlane(tid >> 6), lane = tid & 63, wr = wid >> 2, wc = wid & 3, fr = lane & 15, fq = lane >> 4;
    const int K = g.K, nt = K / BK;
    unsigned voffA[2], voffB[2];
#pragma unroll
    for (int i = 0; i < 2; ++i) { int R, C; stage_rc(tid * 16 + i * 8192, R, C); const int Rb = Epi::PERM ? ((R & ~31) + perm32(R & 31)) : R;
        voffA[i] = (unsigned)(R * K + C) * 2u; voffB[i] = (unsigned)(Rb * K + C) * 2u; }
    const size_t kstep = (size_t)(BK * 2);
    const size_t hstep = (size_t)HALF * K * 2;
    const size_t tstep = 2 * hstep;
    const unsigned ldsw = (unsigned)wid * 1024u;
    const int aoff = lds_byte(wr * 64 + fr, fq * 8), boff = lds_byte(wc * 32 + fr, fq * 8);
#define PG8_SA(b, h) (((b) * 2 + (h)) * HTB)
#define PG8_SB(b, h) ((4 + (b) * 2 + (h)) * HTB)
#define PG8_STAGE(bufoff, gbase, voff) do { _Pragma("unroll") for (int _i = 0; _i < 2; ++_i) \
        __builtin_amdgcn_global_load_lds((const unsigned*)((const char*)(gbase) + (voff)[_i]), (PG8_LAS unsigned*)(lds + (bufoff) + ldsw + _i * 8192), 16, 0, 0); } while (0)
#define PG8_LDA(dst, b, h) do { _Pragma("unroll") for (int m = 0; m < 4; ++m) _Pragma("unroll") for (int k = 0; k < 2; ++k) dst[m][k] = *(const PG8_LAS bf16x8*)(lds + PG8_SA(b, h) + aoff + m * 2048 + k * 1024); } while (0)
#define PG8_LDB(dst, b, h) do { _Pragma("unroll") for (int n = 0; n < 2; ++n) _Pragma("unroll") for (int k = 0; k < 2; ++k) dst[n][k] = *(const PG8_LAS bf16x8*)(lds + PG8_SB(b, h) + boff + n * 2048 + k * 1024); } while (0)
#define PG8_MMA(ai, bj, At, Bt) do { __builtin_amdgcn_s_setprio(1); _Pragma("unroll") for (int m = 0; m < 4; ++m) _Pragma("unroll") for (int n = 0; n < 2; ++n) _Pragma("unroll") for (int k = 0; k < 2; ++k) \
        acc[ai][bj][m][n] = __builtin_amdgcn_mfma_f32_16x16x32_bf16(Bt[n][k], At[m][k], acc[ai][bj][m][n], 0, 0, 0); __builtin_amdgcn_s_setprio(0); } while (0)
#define PG8_WAIT_V(n) asm volatile("s_waitcnt vmcnt(" #n ")" ::: "memory")
#define PG8_WAIT_L(n) asm volatile("s_waitcnt lgkmcnt(" #n ")" ::: "memory")
#define PG8_BAR __builtin_amdgcn_s_barrier()
#define PG8_SCHED __builtin_amdgcn_sched_barrier(0)
    Unit cur, nxt; int ui = 0;
    if (!S.next(0, cur)) return;
    f32x4 acc[2][2][4][2];
#pragma unroll
    for (int a = 0; a < 2; ++a)
#pragma unroll
        for (int b = 0; b < 2; ++b)
#pragma unroll
            for (int m = 0; m < 4; ++m)
#pragma unroll
                for (int n = 0; n < 2; ++n) acc[a][b][m][n] = (f32x4){0.f, 0.f, 0.f, 0.f};
    bf16x8 At[4][2], B0[2][2], B1[2][2];
    const char* cA = (const char*)g.A + (size_t)cur.pm * tstep; const char* cB = (const char*)g.Bt + (size_t)cur.pn * tstep;
    S.a_ready(cur);
    if constexpr (SP2) {
        PG8_STAGE(PG8_SB(0, 0), cB, voffB); PG8_STAGE(PG8_SB(0, 1), cB + hstep, voffB); PG8_STAGE(PG8_SA(0, 0), cA, voffA); PG8_STAGE(PG8_SA(0, 1), cA + hstep, voffA);
        if (wr == 1) PG8_BAR;
        PG8_WAIT_V(2); PG8_BAR;
        PG8_STAGE(PG8_SB(1, 0), cB + kstep, voffB); PG8_STAGE(PG8_SA(1, 0), cA + kstep, voffA); PG8_STAGE(PG8_SB(1, 1), cB + hstep + kstep, voffB);
        PG8_WAIT_V(6); PG8_BAR;
    } else {
        PG8_STAGE(PG8_SB(0, 0), cB, voffB); PG8_STAGE(PG8_SA(0, 0), cA, voffA); PG8_STAGE(PG8_SB(0, 1), cB + hstep, voffB); PG8_STAGE(PG8_SA(0, 1), cA + hstep, voffA);
        if (wr == 1) PG8_BAR;
        PG8_WAIT_V(4); PG8_BAR;
        PG8_STAGE(PG8_SB(1, 0), cB + kstep, voffB); PG8_STAGE(PG8_SA(1, 0), cA + kstep, voffA); PG8_STAGE(PG8_SB(1, 1), cB + hstep + kstep, voffB);
        PG8_WAIT_V(6); PG8_BAR;
    }
    for (;;) {
        const bool has_next = S.next(ui + 1, nxt);
        const char* nA = has_next ? (const char*)g.A + (size_t)nxt.pm * tstep : cA; const char* nB = has_next ? (const char*)g.Bt + (size_t)nxt.pn * tstep : cB;
        for (int t = 0; t < nt; t += 2) {
            const bool last = (t == nt - 2);
            const char* a1 = cA + (size_t)(t + 1) * kstep;
            const char* a2 = last ? nA : cA + (size_t)(t + 2) * kstep; const char* b2 = last ? nB : cB + (size_t)(t + 2) * kstep;
            const char* a3 = a2 + kstep; const char* b3 = b2 + kstep;
            if (last && has_next) S.a_ready(nxt);
            if constexpr (SP2) {
            PG8_LDB(B0, 0, 0); PG8_LDB(B1, 0, 1); PG8_SCHED; PG8_LDA(At, 0, 0); PG8_STAGE(PG8_SA(1, 1), a1 + hstep, voffA);
            PG8_WAIT_V(8); PG8_WAIT_L(0); PG8_BAR; PG8_MMA(0, 0, At, B0); PG8_MMA(0, 1, At, B1); PG8_BAR; PG8_SCHED;
            PG8_LDA(At, 0, 1); PG8_STAGE(PG8_SB(0, 0), b2, voffB); PG8_STAGE(PG8_SB(0, 1), b2 + hstep, voffB); PG8_STAGE(PG8_SA(0, 0), a2, voffA);
            PG8_WAIT_V(8); PG8_WAIT_L(0); PG8_BAR; PG8_MMA(1, 0, At, B0); PG8_MMA(1, 1, At, B1); PG8_BAR; PG8_SCHED;
            PG8_LDB(B0, 1, 0); PG8_LDB(B1, 1, 1); PG8_SCHED; PG8_LDA(At, 1, 0); PG8_STAGE(PG8_SA(0, 1), a2 + hstep, voffA);
            PG8_WAIT_V(8); PG8_WAIT_L(0); PG8_BAR; PG8_MMA(0, 0, At, B0); PG8_MMA(0, 1, At, B1); PG8_BAR; PG8_SCHED;
            PG8_LDA(At, 1, 1); PG8_STAGE(PG8_SB(1, 0), b3, voffB); PG8_STAGE(PG8_SB(1, 1), b3 + hstep, voffB); PG8_STAGE(PG8_SA(1, 0), a3, voffA);
            PG8_WAIT_V(8); PG8_WAIT_L(0); PG8_BAR; PG8_MMA(1, 0, At, B0); PG8_MMA(1, 1, At, B1); PG8_BAR; PG8_SCHED;
            } else {
            PG8_LDB(B0, 0, 0); PG8_SCHED; PG8_LDA(At, 0, 0); PG8_STAGE(PG8_SA(1, 1), a1 + hstep, voffA);
            PG8_WAIT_L(8); PG8_BAR; PG8_WAIT_L(0); PG8_MMA(0, 0, At, B0); PG8_BAR; PG8_SCHED;
            PG8_LDB(B1, 0, 1); PG8_STAGE(PG8_SB(0, 0), b2, voffB);
            PG8_BAR; PG8_WAIT_L(0); PG8_MMA(0, 1, At, B1); PG8_BAR;
            PG8_LDA(At, 0, 1); PG8_STAGE(PG8_SA(0, 0), a2, voffA);
            PG8_BAR; PG8_WAIT_L(0); PG8_MMA(1, 0, At, B0); PG8_BAR; PG8_SCHED;
            PG8_STAGE(PG8_SB(0, 1), b2 + hstep, voffB);
            PG8_WAIT_V(6); PG8_BAR; PG8_MMA(1, 1, At, B1); PG8_BAR;
            PG8_LDB(B0, 1, 0); PG8_SCHED; PG8_LDA(At, 1, 0); PG8_STAGE(PG8_SA(0, 1), a2 + hstep, voffA);
            PG8_WAIT_L(8); PG8_BAR; PG8_WAIT_L(0); PG8_MMA(0, 0, At, B0); PG8_BAR; PG8_SCHED;
            PG8_LDB(B1, 1, 1); PG8_STAGE(PG8_SB(1, 0), b3, voffB);
            PG8_BAR; PG8_WAIT_L(0); PG8_MMA(0, 1, At, B1); PG8_BAR;
            PG8_LDA(At, 1, 1); PG8_STAGE(PG8_SA(1, 0), a3, voffA);
            PG8_BAR; PG8_WAIT_L(0); PG8_MMA(1, 0, At, B0); PG8_BAR; PG8_SCHED;
            PG8_STAGE(PG8_SB(1, 1), b3 + hstep, voffB);
            PG8_WAIT_V(6); PG8_BAR; PG8_MMA(1, 1, At, B1); PG8_BAR;
            }
        }
        if constexpr (ALIGN_EPI) { if (wr == 0) PG8_BAR; }
        if constexpr (!Epi::AFTER_DRAIN) { E(acc, cur, wr, wc, fr, fq); S.done(cur); }
        if (!has_next) break;
#pragma unroll
        for (int a = 0; a < 2; ++a)
#pragma unroll
            for (int b = 0; b < 2; ++b)
#pragma unroll
                for (int m = 0; m < 4; ++m)
#pragma unroll
                    for (int n = 0; n < 2; ++n) acc[a][b][m][n] = (f32x4){0.f, 0.f, 0.f, 0.f};
        cur = nxt; cA = nA; cB = nB; ++ui;
        if constexpr (ALIGN_EPI) { if (wr == 1) PG8_BAR; }
    }
    PG8_WAIT_V(0);
    if constexpr (!ALIGN_EPI) { if (wr == 0) PG8_BAR; }
    PG8_BAR;
    if constexpr (Epi::AFTER_DRAIN) { E.fused(acc, cur, wr, wc, fr, fq, lds, wid, lane); S.done(cur); }
#undef PG8_SA
#undef PG8_SB
#undef PG8_STAGE
#undef PG8_LDA
#undef PG8_LDB
#undef PG8_MMA
#undef PG8_WAIT_V
#undef PG8_WAIT_L
#undef PG8_BAR
#undef PG8_SCHED
}
}
#define GAS __attribute__((address_space(1)))
#define LAS __attribute__((address_space(3)))
typedef unsigned short bf16;
typedef unsigned v4u __attribute__((ext_vector_type(4)));
typedef float f32x4 __attribute__((ext_vector_type(4)));
typedef short bf16x8 __attribute__((ext_vector_type(8)));
typedef GAS unsigned gu32;
typedef GAS unsigned long long gu64;
#define RLX_AGENT __ATOMIC_RELAXED, __HIP_MEMORY_SCOPE_AGENT
#define LDS_WAIT() asm volatile("s_waitcnt lgkmcnt(0)" ::: "memory")
#define VM_WAIT() asm volatile("s_waitcnt vmcnt(0)" ::: "memory")
__device__ __forceinline__ unsigned long long rt() { return __builtin_amdgcn_s_memrealtime(); }
__device__ __forceinline__ unsigned f2bf(float f) { unsigned u = __builtin_bit_cast(unsigned, f); return (u + 0x7fffu + ((u >> 16) & 1u)) >> 16; }
__device__ __forceinline__ unsigned pk2(float lo, float hi) { return f2bf(lo) | (f2bf(hi) << 16); }

#define XB_TMO      128
#define XB_XCNT(j)  (256  + 64 * (j))
#define XB_XSUB(j)  (1280 + 64 * (j))
#define XB_XGEN(j)  (2304 + 64 * (j))
#define XB_TOP      3328
#define XB_TOPGEN   3392
#define XCD_BAR_WORDS 3456
#define XB_SPIN_CAP (1u << 18)

__device__ __forceinline__ unsigned xb_ld(unsigned* p)              { return __hip_atomic_load(p, __ATOMIC_RELAXED, __HIP_MEMORY_SCOPE_AGENT); }
__device__ __forceinline__ unsigned xb_add(unsigned* p, unsigned v) { return __hip_atomic_fetch_add(p, v, __ATOMIC_RELAXED, __HIP_MEMORY_SCOPE_AGENT); }
__device__ __forceinline__ unsigned xb_xcc_id() { return (unsigned)__builtin_amdgcn_s_getreg((3 << 11) | 20) & 0xFu; }
#define XB_SPIN(cond, bar) do { unsigned _sp = 0; while (cond) { __builtin_amdgcn_s_sleep(1); \
    if ((++_sp & 255u) == 0u) { if (xb_ld(&(bar)[XB_TMO])) break; if (_sp > XB_SPIN_CAP) { atomicAdd(&(bar)[XB_TMO], 1u); break; } } } } while (0)

struct XcdBarrier {
    unsigned* bar; unsigned x;
    volatile LAS unsigned* st;
};

__device__ __forceinline__ XcdBarrier xcd_barrier_post(unsigned* bar, volatile LAS unsigned* st) {
    XcdBarrier b; b.bar = bar; b.x = xb_xcc_id(); b.st = st;
    if (threadIdx.x == 0) (void)xb_add(&bar[XB_XCNT(b.x)], 1u);
    return b;
}
__device__ __forceinline__ void xcd_barrier_complete(unsigned* bar, unsigned x, unsigned& nloc, unsigned& nx) {
    const unsigned G = gridDim.x * gridDim.y * gridDim.z;
    unsigned sum, cnt, mine, sp = 0u;
    for (;;) {
        sum = 0u; cnt = 0u; mine = 0u;
#pragma unroll
        for (unsigned j = 0; j < 16; ++j) { const unsigned c = xb_ld(&bar[XB_XCNT(j)]); sum += c; cnt += (c > 0u) ? 1u : 0u; mine = (j == x) ? c : mine; }
        if (sum == G) break;
        __builtin_amdgcn_s_sleep(1);
        if ((++sp & 255u) == 0u) { if (xb_ld(&bar[XB_TMO])) break; if (sp > XB_SPIN_CAP) { atomicAdd(&bar[XB_TMO], 1u); break; } }
    }
    nloc = mine > 0u ? mine : 1u; nx = cnt > 0u ? cnt : 1u;
}

__device__ __forceinline__ void xcd_barrier(const XcdBarrier& b) {
    asm volatile("s_waitcnt vmcnt(0)" ::: "memory");
    __syncthreads();
    if (threadIdx.x == 0) {
        unsigned* bar = b.bar;
        __builtin_amdgcn_s_waitcnt(0);
        unsigned nloc = b.st[0], nx = b.st[1];
        if (nloc == 0u) { xcd_barrier_complete(bar, b.x, nloc, nx); b.st[0] = nloc; b.st[1] = nx; }
        const unsigned old = xb_add(&bar[XB_XSUB(b.x)], 1u);
        const unsigned gen = old / nloc;
        if (old + 1u == (gen + 1u) * nloc) {
            __builtin_amdgcn_fence(__ATOMIC_RELEASE, "agent");
            asm volatile("s_waitcnt vmcnt(0)" ::: "memory");
            const unsigned og = xb_add(&bar[XB_TOP], 1u);
            const unsigned tg = og / nx;
            if (og + 1u == (tg + 1u) * nx) xb_add(&bar[XB_TOPGEN], 1u);
            else XB_SPIN(xb_ld(&bar[XB_TOPGEN]) == tg, bar);
            __builtin_amdgcn_fence(__ATOMIC_ACQUIRE, "agent");
            xb_add(&bar[XB_XGEN(b.x)], 1u);
            asm volatile("s_waitcnt vmcnt(0)" ::: "memory");
        } else {
            XB_SPIN(xb_ld(&bar[XB_XGEN(b.x)]) == gen, bar);
            __builtin_amdgcn_fence(__ATOMIC_ACQUIRE, "agent");
            asm volatile("s_waitcnt vmcnt(0)" ::: "memory");
        }
    }
    __syncthreads();
}
constexpr int D = 1024, BATCH = 16, SEQ = 2048, M = BATCH * SEQ, DFF = 2816, WA = 512, CHUNK = 128, CONVK = 31, NMOD = 9, NADA = NMOD * D;
constexpr float EPS = 1e-6f;
constexpr int NWAVES = 8;
constexpr size_t MiB = 1u << 20;
constexpr size_t WS_CTL = 0, CTL_ZERO_BYTES = 1 * MiB;
constexpr size_t WS_ADA = 1 * MiB;
constexpr size_t WS_W1 = 2 * MiB, WS_W2 = 13 * MiB, WS_W3 = 19 * MiB, WS_W4 = 23 * MiB, WS_W5 = 25 * MiB, WS_W6 = 36 * MiB;
constexpr size_t WS_H = 48 * MiB;
constexpr size_t WS_HID = 112 * MiB;
constexpr size_t WS_U = WS_HID, WS_V = WS_HID + 32 * MiB, WS_GLU = WS_HID + 64 * MiB;
constexpr size_t WS_Y = 288 * MiB;
constexpr size_t WS_F = 352 * MiB;
constexpr size_t WS_END = 480 * MiB;
static_assert(WS_W6 + (size_t)D * DFF * 2 <= WS_H && WS_HID + (size_t)M * DFF * 2 <= WS_Y && WS_Y + (size_t)M * D * 2 <= WS_F && WS_F + (size_t)M * D * 4 <= WS_END, "d_ws map");
constexpr int CW_BAR = 4096;
constexpr int LDS_BYTES = 163840, LDSCTL_OFF = LDS_BYTES - 512, MISC_OFF = LDSCTL_OFF;

struct Frame {
    LAS unsigned char* lds;
    volatile LAS unsigned* MISC;
    int tid, lane, wave, vcu, G;
};
__device__ __forceinline__ float bf2f(unsigned h) { return __uint_as_float(h << 16); }
__device__ __forceinline__ float wave_sum(float v) {
#pragma unroll
    for (int o = 1; o < 64; o <<= 1) v += __shfl_xor(v, o);
    return v;
}
__device__ __forceinline__ float silu_f(float v) { return v / (1.f + __expf(-v)); }

__device__ __forceinline__ void phase_ada(Frame& F, const float* c, const float* w_ada, const float* b_ada, float* ada) {
    LAS float* sc = (LAS float*)F.lds;
    LAS float* red = (LAS float*)(F.lds + 65536);
    if (F.vcu >= NADA / 64) return;
    for (int i = F.tid; i < 16 * 1024; i += 512) { const int b = i >> 10, k = i & 1023; sc[k * 16 + b] = silu_f(c[i]); }
    __syncthreads();
    for (int item = F.vcu; item < NADA / 64; item += F.G) {
        const int col = item * 64 + F.lane, k0 = F.wave * 128;
        float acc[16];
#pragma unroll
        for (int b = 0; b < 16; ++b) acc[b] = 0.f;
        for (int k = k0; k < k0 + 128; ++k) {
            const float wv = w_ada[(size_t)k * NADA + col];
#pragma unroll
            for (int q = 0; q < 4; ++q) { const f32x4 s = *(const LAS f32x4*)&sc[k * 16 + 4 * q];
                acc[4 * q + 0] += s.x * wv; acc[4 * q + 1] += s.y * wv; acc[4 * q + 2] += s.z * wv; acc[4 * q + 3] += s.w * wv; }
        }
#pragma unroll
        for (int b = 0; b < 16; ++b) red[(F.wave * 16 + b) * 64 + F.lane] = acc[b];
        __syncthreads();
        for (int o = F.tid; o < 1024; o += 512) { const int b = o >> 6, l = o & 63; float s = 0.f;
#pragma unroll
            for (int w = 0; w < 8; ++w) s += red[(w * 16 + b) * 64 + l];
            ada[b * NADA + item * 64 + l] = s + b_ada[item * 64 + l]; }
        __syncthreads();
    }
}
__device__ __forceinline__ int dest_row(int mode, int n0) {
    if (mode == 1) { const int up = n0 >= DFF, j = up ? n0 - DFF : n0; return 256 * (j >> 7) + (up ? 128 : 0) + (j & 127); }
    if (mode == 2) { if (n0 < 1024) return n0; const int g = n0 >= 1536, j = n0 - (g ? 1536 : 1024); return 1024 + 256 * (j >> 7) + (g ? 128 : 0) + (j & 127); }
    return n0;
}
__device__ __forceinline__ void transpose_item(const float* W, int K, int N, bf16* WT, int mode, LAS float* scr, int item, int lane) {
    const int nblk = N / 32, kb = item / nblk, nb = item % nblk, k0 = 64 * kb, n0 = 32 * nb, d0 = dest_row(mode, n0);
#pragma unroll 8
    for (int i = 0; i < 32; ++i) { const int kk = 2 * i + (lane >> 5); scr[kk * 33 + (lane & 31)] = W[(size_t)(k0 + kk) * N + n0 + (lane & 31)]; }
    LDS_WAIT(); asm volatile("" ::: "memory");
    const int c = lane & 7;
#pragma unroll
    for (int j = 0; j < 4; ++j) { const int n = (lane >> 3) + 8 * j; const LAS float* s = scr + (8 * c) * 33 + n;
        v4u o; o.x = pk2(s[0 * 33], s[1 * 33]); o.y = pk2(s[2 * 33], s[3 * 33]); o.z = pk2(s[4 * 33], s[5 * 33]); o.w = pk2(s[6 * 33], s[7 * 33]);
        *(GAS v4u*)(WT + (size_t)(d0 + n) * K + k0 + 8 * c) = o; }
    LDS_WAIT(); asm volatile("" ::: "memory");
}
struct WSet { const float *w1, *w2, *w3, *w4, *w5, *w6; bf16 *t1, *t2, *t3, *t4, *t5, *t6; };
__device__ __forceinline__ void phase_wconv(Frame& F, const WSet& w) {
    LAS float* scr = (LAS float*)(F.lds + F.wave * 16384);
    const int gw = F.vcu * NWAVES + F.wave, NGW = F.G * NWAVES;
    constexpr int I_1 = (D / 64) * (2 * DFF / 32), I_2 = (DFF / 64) * (D / 32), I_3 = (D / 64) * (4 * WA / 32), I_4 = (D / 64) * (D / 32);
    constexpr int NITEMS = 2 * I_1 + 2 * I_2 + I_3 + I_4;
    for (int it = gw; it < NITEMS; it += NGW) {
        int r = it;
        if (r < I_1) { transpose_item(w.w1, D, 2 * DFF, w.t1, 1, scr, r, F.lane); continue; } r -= I_1;
        if (r < I_2) { transpose_item(w.w2, DFF, D, w.t2, 0, scr, r, F.lane); continue; } r -= I_2;
        if (r < I_3) { transpose_item(w.w3, D, 4 * WA, w.t3, 2, scr, r, F.lane); continue; } r -= I_3;
        if (r < I_4) { transpose_item(w.w4, D, D, w.t4, 0, scr, r, F.lane); continue; } r -= I_4;
        if (r < I_1) { transpose_item(w.w5, D, 2 * DFF, w.t5, 1, scr, r, F.lane); continue; } r -= I_1;
        transpose_item(w.w6, DFF, D, w.t6, 0, scr, r, F.lane);
    }
}
struct EArgs { const float* xin; const float* f; float* xout; bf16* hout; const float* gpost; const float* gt; const float* gpre; const float* sc; const float* sh; float coef; };
__device__ __forceinline__ void phase_rowpass(Frame& F, const EArgs a) {
    const int lane = F.lane, gw = F.vcu * NWAVES + F.wave, ngw = F.G * NWAVES;
    for (int row = gw; row < M; row += ngw) {
        const int b = row / SEQ;
        f32x4 x[4];
#pragma unroll
        for (int j = 0; j < 4; ++j) x[j] = *(const f32x4*)(a.xin + (size_t)row * D + 4 * lane + 256 * j);
        if (a.f) {
            f32x4 f[4]; float ss = 0.f;
#pragma unroll
            for (int j = 0; j < 4; ++j) { f[j] = *(const f32x4*)(a.f + (size_t)row * D + 4 * lane + 256 * j); ss += f[j].x * f[j].x + f[j].y * f[j].y + f[j].z * f[j].z + f[j].w * f[j].w; }
            const float rstd = rsqrtf(wave_sum(ss) * (1.f / D) + EPS);
#pragma unroll
            for (int j = 0; j < 4; ++j) { const int col = 4 * lane + 256 * j; const f32x4 g = *(const f32x4*)(a.gpost + col), t = *(const f32x4*)(a.gt + (size_t)b * NADA + col);
                x[j] = x[j] + (t * a.coef) * (f[j] * rstd * g);
                *(f32x4*)(a.xout + (size_t)row * D + col) = x[j]; }
        }
        if (a.hout) {
            float ss = 0.f;
#pragma unroll
            for (int j = 0; j < 4; ++j) ss += x[j].x * x[j].x + x[j].y * x[j].y + x[j].z * x[j].z + x[j].w * x[j].w;
            const float rstd = rsqrtf(wave_sum(ss) * (1.f / D) + EPS);
#pragma unroll
            for (int j = 0; j < 4; ++j) { const int col = 4 * lane + 256 * j; const f32x4 g = *(const f32x4*)(a.gpre + col), s = *(const f32x4*)(a.sc + (size_t)b * NADA + col), h = *(const f32x4*)(a.sh + (size_t)b * NADA + col);
                const f32x4 o = x[j] * rstd * g * (s + 1.0f) + h;
                uint2 w; w.x = pk2(o.x, o.y); w.y = pk2(o.z, o.w); *(uint2*)(a.hout + (size_t)row * D + col) = w; }
        }
    }
}
constexpr int MX_VT_PITCH = 272, MX_VT_SLICE = 64 * MX_VT_PITCH, MX_STAT_OFF = 8 * MX_VT_SLICE, MX_PART_OFF = MX_STAT_OFF + 1024, MX_END = MX_PART_OFF + 4096;
static_assert(MX_END <= LDSCTL_OFF, "mixer LDS map");
struct MixArgs { const bf16 *U, *V, *GLU; const float *gmlp_g, *gmlp_b, *w_sp, *b_sp, *conv_w, *conv_b, *cn_g, *cn_b, *g_out_a, *g_out_b; bf16* Y; };
__device__ __forceinline__ void unpack8(const uint4 w, float (&v)[8]) {
    v[0] = bf2f(w.x & 0xffffu); v[1] = bf2f(w.x >> 16); v[2] = bf2f(w.y & 0xffffu); v[3] = bf2f(w.y >> 16); v[4] = bf2f(w.z & 0xffffu); v[5] = bf2f(w.z >> 16); v[6] = bf2f(w.w & 0xffffu); v[7] = bf2f(w.w >> 16);
}
__device__ __forceinline__ void phase_mixer(Frame& F, const MixArgs a) {
    const int lane = F.lane, wave = F.wave, tid = F.tid, fr = lane & 15, fq = lane >> 4, h = wave;
    LAS float* stat = (LAS float*)(F.lds + MX_STAT_OFF);
    LAS float* part = (LAS float*)(F.lds + MX_PART_OFF);
    LAS unsigned char* vt = F.lds + wave * MX_VT_SLICE;
    LAS float* cvs = (LAS float*)F.lds;
    for (int unit = F.vcu; unit < M / CHUNK; unit += F.G) {
        const int r0 = unit * CHUNK;
#pragma unroll 4
        for (int i = 0; i < 16; ++i) { const int row = 16 * wave + i; float v[8]; unpack8(*(const uint4*)(a.V + (size_t)(r0 + row) * WA + 8 * lane), v);
            float s = 0.f;
#pragma unroll
            for (int e = 0; e < 8; ++e) s += v[e];
            const float mu = wave_sum(s) * (1.f / WA); float q = 0.f;
#pragma unroll
            for (int e = 0; e < 8; ++e) { const float d = v[e] - mu; q += d * d; }
            const float rstd = rsqrtf(wave_sum(q) * (1.f / WA) + EPS);
            if (lane == 0) { stat[2 * row] = mu; stat[2 * row + 1] = rstd; } }
        __syncthreads();
        { const float mu0 = stat[4 * lane], rs0 = stat[4 * lane + 1], mu1 = stat[4 * lane + 2], rs1 = stat[4 * lane + 3];
          const bf16* vp = a.V + (size_t)(r0 + 2 * lane) * WA + h * 64;
#pragma unroll 2
          for (int p = 0; p < 8; ++p) { float v0[8], v1[8]; unpack8(*(const uint4*)(vp + 8 * p), v0); unpack8(*(const uint4*)(vp + WA + 8 * p), v1);
#pragma unroll
              for (int e = 0; e < 8; ++e) { const float g = a.gmlp_g[h * 64 + 8 * p + e], b = a.gmlp_b[h * 64 + 8 * p + e];
                  *(LAS unsigned*)(vt + (8 * p + e) * MX_VT_PITCH + 4 * lane) = pk2((v0[e] - mu0) * rs0 * g + b, (v1[e] - mu1) * rs1 * g + b); } } }
        asm volatile("" ::: "memory");
        pg8::f32x4 acc[8][4];
#pragma unroll
        for (int m = 0; m < 8; ++m)
#pragma unroll
            for (int n = 0; n < 4; ++n) acc[m][n] = (pg8::f32x4){0.f, 0.f, 0.f, 0.f};
#pragma unroll
        for (int m = 0; m < 8; ++m)
#pragma unroll
            for (int kk = 0; kk < 4; ++kk) if (32 * kk <= 16 * m + 15) {
                const int t = 16 * m + fr, s0 = 32 * kk + 8 * fq;
                const float* wp = a.w_sp + ((size_t)h * CHUNK + t) * CHUNK + s0;
                const pg8::f32x4 w0 = *(const pg8::f32x4*)wp, w1 = *(const pg8::f32x4*)(wp + 4);
                float wv[8] = {w0[0], w0[1], w0[2], w0[3], w1[0], w1[1], w1[2], w1[3]};
                if (32 * kk + 31 > 16 * m) {
                    const int lim = t - s0;
#pragma unroll
                    for (int e = 0; e < 8; ++e) wv[e] = (e <= lim) ? wv[e] : 0.f; }
                pg8::u32x4 wq; wq.x = pg8::cvt_pk_bf16(wv[0], wv[1]); wq.y = pg8::cvt_pk_bf16(wv[2], wv[3]); wq.z = pg8::cvt_pk_bf16(wv[4], wv[5]); wq.w = pg8::cvt_pk_bf16(wv[6], wv[7]);
                const pg8::bf16x8 wf = __builtin_bit_cast(pg8::bf16x8, wq);
#pragma unroll
                for (int n = 0; n < 4; ++n) { const pg8::bf16x8 vf = *(const LAS pg8::bf16x8*)(vt + (16 * n + fr) * MX_VT_PITCH + (32 * kk + 8 * fq) * 2);
                    acc[m][n] = __builtin_amdgcn_mfma_f32_16x16x32_bf16(vf, wf, acc[m][n], 0, 0, 0); }
                __builtin_amdgcn_sched_barrier(0);
            }
        int fr2 = fr, fq2 = fq; asm volatile("" : "+v"(fr2), "+v"(fq2));
#pragma unroll
        for (int m = 0; m < 8; ++m) { const int t = 16 * m + fr2; const float bias = a.b_sp[h * CHUNK + t]; float ss = 0.f;
#pragma unroll
            for (int n = 0; n < 4; ++n) { const uint2 uw = *(const uint2*)(a.U + (size_t)(r0 + t) * WA + h * 64 + 16 * n + 4 * fq2);
                pg8::f32x4 y; y[0] = bf2f(uw.x & 0xffffu) * (acc[m][n][0] + bias); y[1] = bf2f(uw.x >> 16) * (acc[m][n][1] + bias); y[2] = bf2f(uw.y & 0xffffu) * (acc[m][n][2] + bias); y[3] = bf2f(uw.y >> 16) * (acc[m][n][3] + bias);
                acc[m][n] = y; ss += (y[0] * y[0] + y[1] * y[1]) + (y[2] * y[2] + y[3] * y[3]); }
            ss += __shfl_xor(ss, 16); ss += __shfl_xor(ss, 32);
            if (fq2 == 0) part[t * 8 + h] = ss; }
        __syncthreads();
        asm volatile("" : "+v"(fr2), "+v"(fq2));
#pragma unroll
        for (int m = 0; m < 8; ++m) { const int t = 16 * m + fr2; const pg8::f32x4 p0 = *(const LAS pg8::f32x4*)(part + t * 8), p1 = *(const LAS pg8::f32x4*)(part + t * 8 + 4);
            const float rstd = rsqrtf(((p0[0] + p0[1]) + (p0[2] + p0[3]) + (p1[0] + p1[1]) + (p1[2] + p1[3])) * (1.f / WA) + EPS);
#pragma unroll
            for (int n = 0; n < 4; ++n) { const int col = h * 64 + 16 * n + 4 * fq2; const pg8::f32x4 g = *(const pg8::f32x4*)(a.g_out_a + col); const pg8::f32x4 y = acc[m][n] * rstd * g;
                uint2 w; w.x = pg8::cvt_pk_bf16(y[0], y[1]); w.y = pg8::cvt_pk_bf16(y[2], y[3]); *(uint2*)(a.Y + (size_t)(r0 + t) * D + col) = w; } }
        __syncthreads();
        { int c = tid, l8 = 8 * lane; asm volatile("" : "+v"(c), "+v"(l8));
          const int p0 = r0 % SEQ;
          float cw[CONVK];
#pragma unroll
          for (int j = 0; j < CONVK; ++j) cw[j] = a.conv_w[j * WA + c];
          const float cb = a.conv_b[c];
          float ng[8], nb[8], go[8];
#pragma unroll
          for (int e = 0; e < 8; ++e) { ng[e] = a.cn_g[l8 + e]; nb[e] = a.cn_b[l8 + e]; go[e] = a.g_out_b[l8 + e]; }
          for (int sb = 0; sb < 4; ++sb) { const int t0 = 32 * sb;
              float g[32 + CONVK - 1];
#pragma unroll
              for (int i = 0; i < 32 + CONVK - 1; ++i) { const int rr = t0 - (CONVK - 1) + i; g[i] = (p0 + rr >= 0) ? bf2f(a.GLU[(size_t)(r0 + rr) * WA + c]) : 0.f; }
#pragma unroll
              for (int t = 0; t < 32; ++t) { float s = cb;
#pragma unroll
                  for (int j = 0; j < CONVK; ++j) s += cw[j] * g[t + j];
                  cvs[t * WA + c] = s; }
              __syncthreads();
#pragma unroll
              for (int i = 0; i < 4; ++i) { const int t = 4 * wave + i; const pg8::f32x4 q0 = *(const LAS pg8::f32x4*)(cvs + t * WA + 8 * lane), q1 = *(const LAS pg8::f32x4*)(cvs + t * WA + 8 * lane + 4);
                  float cv[8] = {q0[0], q0[1], q0[2], q0[3], q1[0], q1[1], q1[2], q1[3]}; float s = 0.f;
#pragma unroll
                  for (int e = 0; e < 8; ++e) s += cv[e];
                  const float mu = wave_sum(s) * (1.f / WA); float q = 0.f;
#pragma unroll
                  for (int e = 0; e < 8; ++e) { cv[e] -= mu; q += cv[e] * cv[e]; }
                  const float rc = rsqrtf(wave_sum(q) * (1.f / WA) + EPS); float s2 = 0.f;
#pragma unroll
                  for (int e = 0; e < 8; ++e) { const float z = cv[e] * rc * ng[e] + nb[e]; cv[e] = z * pg8::fast_sigmoid(z); s2 += cv[e] * cv[e]; }
                  const float rb = rsqrtf(wave_sum(s2) * (1.f / WA) + EPS);
                  uint4 w; w.x = pg8::cvt_pk_bf16(cv[0] * rb * go[0], cv[1] * rb * go[1]); w.y = pg8::cvt_pk_bf16(cv[2] * rb * go[2], cv[3] * rb * go[3]);
                  w.z = pg8::cvt_pk_bf16(cv[4] * rb * go[4], cv[5] * rb * go[5]); w.w = pg8::cvt_pk_bf16(cv[6] * rb * go[6], cv[7] * rb * go[7]);
                  *(uint4*)(a.Y + (size_t)(r0 + t0 + t) * D + WA + 8 * lane) = w; }
              __syncthreads(); }
        }
    }
}
#ifndef MK_PER_PHASE
#define MK_PER_PHASE 0
#endif
constexpr int N_PHASES = 12;
struct Args { const float* in[26]; float* out; unsigned char* ws; int ph_lo, ph_hi; };
__global__ void __launch_bounds__(NWAVES * 64, 2) mk_fwd(Args args) {
    extern __shared__ __attribute__((aligned(16))) unsigned char lds[];
    Frame F;
    F.lds = (LAS unsigned char*)lds;
    F.MISC = (volatile LAS unsigned*)(F.lds + MISC_OFF);
    F.tid = threadIdx.x; F.lane = F.tid & 63; F.wave = __builtin_amdgcn_readfirstlane(F.tid >> 6);
    F.G = gridDim.x; { const int bx = blockIdx.x; F.vcu = (F.G % 8 == 0) ? (bx % 8) * (F.G / 8) + bx / 8 : bx; }
    unsigned char* ws = args.ws;
    gu32* ctl = (gu32*)(ws + WS_CTL);
    for (int u = F.tid; u < (LDS_BYTES - LDSCTL_OFF) / 4; u += NWAVES * 64) ((LAS unsigned*)(F.lds + LDSCTL_OFF))[u] = 0u;
    __syncthreads();
    XcdBarrier bar = xcd_barrier_post((unsigned*)(ctl + CW_BAR), F.MISC + 8);
    const int lo = args.ph_lo, hi = args.ph_hi;
#define IN(k) (lo <= (k) && (k) < hi)
#define SEAM(k) do { if (IN(k) && IN((k) + 1)) xcd_barrier(bar); } while (0)
    const float *x = args.in[0], *c = args.in[1], *w_ada = args.in[2], *b_ada = args.in[3], *g_pre_f1 = args.in[4], *g_post_f1 = args.in[5], *g_pre_m = args.in[8], *g_post_m = args.in[9],
                *gmlp_g = args.in[11], *gmlp_b = args.in[12], *w_sp = args.in[13], *b_sp = args.in[14], *conv_w = args.in[15], *conv_b = args.in[16], *cn_g = args.in[17], *cn_b = args.in[18],
                *g_out_a = args.in[19], *g_out_b = args.in[20], *g_pre_f2 = args.in[22], *g_post_f2 = args.in[23];
    float* out = args.out;
    float* ada = (float*)(ws + WS_ADA); bf16* H = (bf16*)(ws + WS_H); bf16* HID = (bf16*)(ws + WS_HID); bf16* Y = (bf16*)(ws + WS_Y); float* Fb = (float*)(ws + WS_F);
    bf16 *U = (bf16*)(ws + WS_U), *V = (bf16*)(ws + WS_V), *GLU = (bf16*)(ws + WS_GLU);
    bf16 *W1 = (bf16*)(ws + WS_W1), *W2 = (bf16*)(ws + WS_W2), *W3 = (bf16*)(ws + WS_W3), *W4 = (bf16*)(ws + WS_W4), *W5 = (bf16*)(ws + WS_W5), *W6 = (bf16*)(ws + WS_W6);
    const float *sh1 = ada, *sc1 = ada + D, *gt1 = ada + 2 * D, *sh2 = ada + 3 * D, *sc2 = ada + 4 * D, *gt2 = ada + 5 * D, *sh3 = ada + 6 * D, *sc3 = ada + 7 * D, *gt3 = ada + 8 * D;

    if (IN(0)) { phase_ada(F, c, w_ada, b_ada, ada); __syncthreads();
                 phase_wconv(F, WSet{args.in[6], args.in[7], args.in[10], args.in[21], args.in[24], args.in[25], W1, W2, W3, W4, W5, W6}); }
    SEAM(0);
    if (IN(1)) phase_rowpass(F, EArgs{x, nullptr, nullptr, H, nullptr, nullptr, g_pre_f1, sc1, sh1, 0.f});
    SEAM(1);
    if (IN(2)) { pg8::Gemm g{H, W1, M, 2 * DFF, D}; pg8::StaticOrder S; S.init(M, 2 * DFF, F.G, (int)blockIdx.x); pg8::EpiSwiglu E{HID, DFF};
                 pg8::gemm_phase<pg8::EpiSwiglu, pg8::StaticOrder, true, true>(F.lds, g, S, E); }
    SEAM(2);
    if (IN(3)) { pg8::Gemm g{HID, W2, M, D, DFF}; pg8::StaticOrder S; S.init(M, D, F.G, (int)blockIdx.x); pg8::EpiF32 E{Fb, D};
                 pg8::gemm_phase<pg8::EpiF32, pg8::StaticOrder, true, true>(F.lds, g, S, E); }
    SEAM(3);
    if (IN(4)) phase_rowpass(F, EArgs{x, Fb, out, H, g_post_f1, gt1, g_pre_m, sc2, sh2, 0.5f});
    SEAM(4);
    if (IN(5)) { pg8::Gemm g{H, W3, M, 4 * WA, D}; pg8::StaticOrder S; S.init(M, 4 * WA, F.G, (int)blockIdx.x); pg8::EpiMixIn E{U, V, GLU};
                 pg8::gemm_phase<pg8::EpiMixIn, pg8::StaticOrder, true, true>(F.lds, g, S, E); }
    SEAM(5);
    if (IN(6)) phase_mixer(F, MixArgs{U, V, GLU, gmlp_g, gmlp_b, w_sp, b_sp, conv_w, conv_b, cn_g, cn_b, g_out_a, g_out_b, Y});
    SEAM(6);
    if (IN(7)) { pg8::Gemm g{Y, W4, M, D, D}; pg8::StaticOrder S; S.init(M, D, F.G, (int)blockIdx.x); pg8::EpiF32 E{Fb, D};
                 pg8::gemm_phase<pg8::EpiF32, pg8::StaticOrder, true, true>(F.lds, g, S, E); }
    SEAM(7);
    if (IN(8)) phase_rowpass(F, EArgs{out, Fb, out, H, g_post_m, gt2, g_pre_f2, sc3, sh3, 1.0f});
    SEAM(8);
    if (IN(9)) { pg8::Gemm g{H, W5, M, 2 * DFF, D}; pg8::StaticOrder S; S.init(M, 2 * DFF, F.G, (int)blockIdx.x); pg8::EpiSwiglu E{HID, DFF};
                 pg8::gemm_phase<pg8::EpiSwiglu, pg8::StaticOrder, true, true>(F.lds, g, S, E); }
    SEAM(9);
    if (IN(10)) { pg8::Gemm g{HID, W6, M, D, DFF}; pg8::StaticOrder S; S.init(M, D, F.G, (int)blockIdx.x); pg8::EpiF32 E{Fb, D};
                  pg8::gemm_phase<pg8::EpiF32, pg8::StaticOrder, true, true>(F.lds, g, S, E); }
    SEAM(10);
    if (IN(11)) phase_rowpass(F, EArgs{out, Fb, out, nullptr, g_post_f2, gt3, nullptr, nullptr, nullptr, 0.5f});
#undef IN
#undef SEAM
}

extern "C" void kernel_launch(void* const* d_in, const int* in_sizes, int n_in, void* d_out, int out_size, void* d_ws, size_t ws_size, hipStream_t stream) {
    static int grid = 0;
    if (grid == 0) {
        if (n_in != 26 || in_sizes[0] != M * D || out_size != M * D || ws_size < WS_END) { fprintf(stderr, "kernel_launch: unexpected shapes (n_in %d, in0 %d, out %d, ws %zu)\n", n_in, n_in > 0 ? in_sizes[0] : -1, out_size, ws_size); grid = -1; return; }
        int dev = 0, cus = 0, per_cu = 0;
        if (hipGetDevice(&dev) != hipSuccess || hipDeviceGetAttribute(&cus, hipDeviceAttributeMultiprocessorCount, dev) != hipSuccess) { fprintf(stderr, "kernel_launch: device query failed\n"); grid = -1; return; }
        if (hipFuncSetAttribute((const void*)mk_fwd, hipFuncAttributeMaxDynamicSharedMemorySize, LDS_BYTES) != hipSuccess) { fprintf(stderr, "kernel_launch: hipFuncSetAttribute failed\n"); grid = -1; return; }
        if (hipOccupancyMaxActiveBlocksPerMultiprocessor(&per_cu, (const void*)mk_fwd, NWAVES * 64, LDS_BYTES) != hipSuccess || per_cu < 1) fprintf(stderr, "kernel_launch: note: occupancy query reports %d workgroups per CU\n", per_cu);
        (void)hipGetLastError();
        grid = cus;
    }
    if (grid < 0) return;
    if (hipMemsetAsync((char*)d_ws + WS_CTL, 0, CTL_ZERO_BYTES, stream) != hipSuccess) { fprintf(stderr, "kernel_launch: memset failed\n"); return; }
    Args a{};
    for (int i = 0; i < 26; ++i) a.in[i] = (const float*)d_in[i];
    a.out = (float*)d_out; a.ws = (unsigned char*)d_ws;
#if MK_PER_PHASE
    for (int p = 0; p < N_PHASES; ++p) { a.ph_lo = p; a.ph_hi = p + 1; hipLaunchKernelGGL(mk_fwd, dim3(grid), dim3(NWAVES * 64), LDS_BYTES, stream, a); }
#else
    a.ph_lo = 0; a.ph_hi = N_PHASES;
    hipLaunchKernelGGL(mk_fwd, dim3(grid), dim3(NWAVES * 64), LDS_BYTES, stream, a);
#endif
    const hipError_t le = hipPeekAtLastError();
    if (le != hipSuccess) fprintf(stderr, "kernel_launch: launch failed: %s (grid %d)\n", hipGetErrorName(le), grid);
}
```
